# Optimizing an MI355X kernel written in HIP

```python
import math
import jax, jax.numpy as jnp
from jax import lax
import numpy as np

D_MODEL = 1024
BATCH = 4
SEQ = 8192
DEPTH = 2

HEAD_DIM = 64
A_GROUPS = ((128, 1), (512, 4), (2048, 16))
A_N_GROUPS = 3
A_HEADS_PER_GROUP = 8
A_HEADS = A_N_GROUPS * A_HEADS_PER_GROUP
A_QKV_WIDTH = A_HEADS * HEAD_DIM
A_WIDTH = A_HEADS_PER_GROUP * HEAD_DIM
A_Q_BLOCK = 64
B_Q_HEADS = 8
B_KV_HEADS = 2
B_WIDTH = B_Q_HEADS * HEAD_DIM
B_KV_WIDTH = B_KV_HEADS * HEAD_DIM
B_Q_BLOCK = 128
GRID_W = 64
ROPE_THETA = 10000.0
REL_BUCKETS = 32
REL_MAX_DISTANCE = 1024
LN_EPS = 1e-5
QK_EPS = 1e-6
NEG_INF = -1e30
DEEPNORM_ALPHA = float((2 * DEPTH) ** 0.25)
DEEPNORM_BETA = float((8 * DEPTH) ** -0.25)
SPLITS = (A_QKV_WIDTH, A_QKV_WIDTH, A_QKV_WIDTH, A_WIDTH,
          B_WIDTH, B_KV_WIDTH, B_KV_WIDTH, B_WIDTH, 2 * D_MODEL)
SPLIT_POINTS = tuple(int(v) for v in np.cumsum(SPLITS)[:-1])
IN_WIDTH = int(sum(SPLITS))

kernel_name = "hybrid_dilated_gqa_gated_encoder"


def t5_bucket(rel):
    half = REL_BUCKETS // 2
    max_exact = half // 2
    ret = jnp.where(rel > 0, half, 0)
    a = jnp.abs(rel)
    af = jnp.maximum(a, 1).astype(jnp.float32)
    large = max_exact + (jnp.log(af / max_exact) / math.log(REL_MAX_DISTANCE / max_exact)
                         * (half - max_exact)).astype(jnp.int32)
    large = jnp.minimum(large, half - 1)
    return ret + jnp.where(a < max_exact, a, large)


def dilated_window_attention(q, k, v, table_g, window, dilation):
    B, S, H, E = q.shape
    d = dilation
    R = window // (2 * d)
    L = S // d
    Qb = math.gcd(L, A_Q_BLOCK)
    nblk = L // Qb
    Kw = Qb + 2 * R

    def phases(a):
        return a.reshape(B, L, d, H, E).transpose(0, 2, 3, 1, 4)

    qp = phases(q).reshape(B, d, H, nblk, Qb, E)
    pad = ((0, 0), (0, 0), (0, 0), (R, R), (0, 0))
    idx = jnp.arange(nblk)[:, None] * Qb + jnp.arange(Kw)[None, :]
    kb = jnp.pad(phases(k), pad)[:, :, :, idx]
    vb = jnp.pad(phases(v), pad)[:, :, :, idx]
    rel = jnp.arange(Kw)[None, :] - R - jnp.arange(Qb)[:, None]
    bias = table_g[t5_bucket(rel * d)].transpose(2, 0, 1).astype(jnp.float32)
    key_pos = idx - R
    valid = (jnp.abs(rel) <= R)[None] & ((key_pos >= 0) & (key_pos < L))[:, None, :]
    logits = jnp.einsum('bdhnqe,bdhnke->bdhnqk', qp, kb,
                        preferred_element_type=jnp.float32) * (E ** -0.5)
    logits = jnp.where(valid, logits + bias[None, None, :, None], NEG_INF)
    m = jnp.max(logits, axis=-1, keepdims=True)
    p = jnp.exp(logits - m)
    s = jnp.sum(p, axis=-1, keepdims=True)
    o = jnp.einsum('bdhnqk,bdhnke->bdhnqe', p, vb.astype(jnp.float32)) / s
    lse = (m + jnp.log(s))[..., 0]
    o = o.reshape(B, d, H, L, E).transpose(0, 3, 1, 2, 4).reshape(B, S, H, E)
    lse = lse.reshape(B, d, H, L).transpose(0, 3, 1, 2).reshape(B, S, H)
    return o, lse


def mixer_a(q, k, v, rel_table):
    B, S, _ = q.shape
    shp = (B, S, A_N_GROUPS, A_HEADS_PER_GROUP, HEAD_DIM)
    q, k, v = q.reshape(shp), k.reshape(shp), v.reshape(shp)
    outs, lses = [], []
    for g, (window, dil) in enumerate(A_GROUPS):
        table_g = rel_table[:, g * A_HEADS_PER_GROUP:(g + 1) * A_HEADS_PER_GROUP]
        o_g, l_g = dilated_window_attention(q[:, :, g], k[:, :, g], v[:, :, g], table_g, window, dil)
        outs.append(o_g)
        lses.append(l_g)
    w = jax.nn.softmax(jnp.stack(lses, axis=0), axis=0)
    o = jnp.sum(w[..., None] * jnp.stack(outs, axis=0), axis=0)
    return o.reshape(B, S, A_WIDTH).astype(q.dtype)


def rms_head(x, g):
    xf = x.astype(jnp.float32)
    y = xf * lax.rsqrt(jnp.mean(xf * xf, axis=-1, keepdims=True) + QK_EPS) * g.astype(jnp.float32)
    return y.astype(x.dtype)


def axial_angles(S):
    rows = S // GRID_W
    row_ids = jnp.repeat(jnp.arange(rows), GRID_W).astype(jnp.float32)
    col_ids = jnp.tile(jnp.arange(GRID_W), rows).astype(jnp.float32)
    half = HEAD_DIM // 2
    inv = ROPE_THETA ** (-jnp.arange(0, half, 2, dtype=jnp.float32) / half)
    return row_ids[:, None] * inv[None], col_ids[:, None] * inv[None]


def rotate_half_rope(x, ang):
    n = ang.shape[-1]
    x1, x2 = x[..., :n], x[..., n:]
    cos = jnp.cos(ang)[None, :, None, :]
    sin = jnp.sin(ang)[None, :, None, :]
    return jnp.concatenate([x1 * cos - x2 * sin, x2 * cos + x1 * sin], axis=-1)


def axial_rope(x, ang_row, ang_col):
    xf = x.astype(jnp.float32)
    half = HEAD_DIM // 2
    y = jnp.concatenate([rotate_half_rope(xf[..., :half], ang_row),
                         rotate_half_rope(xf[..., half:], ang_col)], axis=-1)
    return y.astype(x.dtype)


def mixer_b(q, k, v, q_norm_g, k_norm_g):
    B, S, _ = q.shape
    q = q.reshape(B, S, B_Q_HEADS, HEAD_DIM)
    k = k.reshape(B, S, B_KV_HEADS, HEAD_DIM)
    v = v.reshape(B, S, B_KV_HEADS, HEAD_DIM)
    ang_row, ang_col = axial_angles(S)
    q = axial_rope(rms_head(q, q_norm_g), ang_row, ang_col)
    k = axial_rope(rms_head(k, k_norm_g), ang_row, ang_col)
    G = B_Q_HEADS // B_KV_HEADS
    nq = S // B_Q_BLOCK
    qb = q.reshape(B, nq, B_Q_BLOCK, B_KV_HEADS, G, HEAD_DIM).transpose(1, 0, 2, 3, 4, 5)

    def one_block(qblk):
        logits = jnp.einsum('bqkge,bske->bkgqs', qblk, k,
                            preferred_element_type=jnp.float32) * (HEAD_DIM ** -0.5)
        p = jax.nn.softmax(logits, axis=-1).astype(v.dtype)
        return jnp.einsum('bkgqs,bske->bqkge', p, v)

    o = lax.map(one_block, qb)
    return o.transpose(1, 0, 2, 3, 4, 5).reshape(B, S, B_WIDTH)


def layer_norm(h, g, b):
    hf = h.astype(jnp.float32)
    mu = jnp.mean(hf, axis=-1, keepdims=True)
    var = jnp.mean(jnp.square(hf - mu), axis=-1, keepdims=True)
    y = (hf - mu) * lax.rsqrt(var + LN_EPS) * g.astype(jnp.float32) + b.astype(jnp.float32)
    return y.astype(h.dtype)


def hybrid_layer(x, c, rel_table, ln_g, ln_b, w_ada, b_ada, w_in, b_gate,
                 q_norm_g, k_norm_g, w_pa, w_pb, w_o):
    mod = jax.nn.silu(c) @ w_ada + b_ada
    shift, scale, gate = jnp.split(mod, 3, axis=-1)
    u = x * (1.0 + scale[:, None, :]) + shift[:, None, :]
    proj = u @ w_in
    aq, ak, av, az, bq, bk, bv, bz, gl = jnp.split(proj, SPLIT_POINTS, axis=-1)
    y_a = mixer_a(aq, ak, av, rel_table) * jax.nn.silu(az)
    y_b = mixer_b(bq, bk, bv, q_norm_g, k_norm_g) * jax.nn.silu(bz)
    g_a, g_b = jnp.split(jax.nn.sigmoid(gl + b_gate), 2, axis=-1)
    merged = g_a * (y_a @ w_pa) + g_b * (y_b @ w_pb)
    out = merged @ w_o
    return layer_norm(DEEPNORM_ALPHA * x + gate[:, None, :] * out, ln_g, ln_b)


def setup_inputs(seed: int = 0) -> dict:
    key = jax.random.key(seed)
    ks = jax.random.split(key, 16)
    f32 = jnp.float32
    D = D_MODEL
    x = jax.random.normal(ks[0], (BATCH, SEQ, D), f32)
    c = jax.random.normal(ks[1], (BATCH, D), f32)
    rel_table = 0.2 * jax.random.normal(ks[2], (REL_BUCKETS, A_HEADS), f32)
    ln_g = 1.0 + 0.02 * jax.random.normal(ks[3], (DEPTH, D), f32)
    ln_b = 0.02 * jax.random.normal(ks[4], (DEPTH, D), f32)
    w_ada = jax.random.normal(ks[5], (DEPTH, D, 3 * D), f32) * (D ** -0.5)
    b_ada = 0.02 * jax.random.normal(ks[6], (DEPTH, 3 * D), f32)
    col_scale = np.concatenate([
        np.full((n,), DEEPNORM_BETA if i in (2, 6) else 1.0, np.float32)
        for i, n in enumerate(SPLITS)])
    w_in = jax.random.normal(ks[7], (DEPTH, D, IN_WIDTH), f32) * (D ** -0.5) * jnp.asarray(col_scale)
    b_gate = 0.02 * jax.random.normal(ks[8], (DEPTH, 2 * D), f32)
    q_norm_g = 1.0 + 0.02 * jax.random.normal(ks[9], (DEPTH, HEAD_DIM), f32)
    k_norm_g = 1.0 + 0.02 * jax.random.normal(ks[10], (DEPTH, HEAD_DIM), f32)
    w_pa = jax.random.normal(ks[11], (DEPTH, A_WIDTH, D), f32) * (A_WIDTH ** -0.5) * DEEPNORM_BETA
    w_pb = jax.random.normal(ks[12], (DEPTH, B_WIDTH, D), f32) * (B_WIDTH ** -0.5) * DEEPNORM_BETA
    w_o = jax.random.normal(ks[13], (DEPTH, D, D), f32) * (D ** -0.5) * DEEPNORM_BETA
    return {"x": x, "c": c, "rel_table": rel_table, "ln_g": ln_g, "ln_b": ln_b,
            "w_ada": w_ada, "b_ada": b_ada, "w_in": w_in, "b_gate": b_gate,
            "q_norm_g": q_norm_g, "k_norm_g": k_norm_g, "w_pa": w_pa, "w_pb": w_pb, "w_o": w_o}


def reference(x, c, rel_table, ln_g, ln_b, w_ada, b_ada, w_in, b_gate,
              q_norm_g, k_norm_g, w_pa, w_pb, w_o):
    for l in range(DEPTH):
        x = hybrid_layer(x, c, rel_table, ln_g[l], ln_b[l], w_ada[l], b_ada[l], w_in[l], b_gate[l],
                         q_norm_g[l], k_norm_g[l], w_pa[l], w_pb[l], w_o[l])
    return x
```

```cpp
#include <hip/hip_runtime.h>
#include <hip/hip_cooperative_groups.h>
#include <cstdio>
#include <cstdint>
namespace cg = cooperative_groups;
constexpr int NB = 4, SEQ = 8192, DM = 1024, MT = NB * SEQ, DEPTH = 2;
constexpr int N1 = 6400, NIN = 8448;
constexpr float ALPHA = 1.41421356237309515f;
constexpr float LOG2E = 1.44269504088896341f;
constexpr float QK_C = 0.125f * LOG2E;
constexpr int LDS_BYTES = 131072;

constexpr size_t WS_MOD = 0;
constexpr size_t WS_ROPE = 128 * 1024;
constexpr size_t WS_BIAS = 160 * 1024;
constexpr size_t WS_LSE = 256 * 1024;
constexpr size_t WS_W1T = WS_LSE + (size_t)3 * 4 * 8 * 8192 * 4;
constexpr size_t WS_WPAT = WS_W1T + (size_t)2 * NIN * 1024 * 2;
constexpr size_t WS_WPBT = WS_WPAT + (size_t)2 * 1024 * 512 * 2;
constexpr size_t WS_WOT = WS_WPBT + (size_t)2 * 1024 * 512 * 2;
constexpr size_t WS_U = WS_WOT + (size_t)2 * 1024 * 1024 * 2;
constexpr size_t WS_QA = WS_U + (size_t)MT * 1024 * 2;
constexpr size_t SZ_A = (size_t)NB * 3 * 8 * SEQ * 64 * 2;
constexpr size_t WS_KA = WS_QA + SZ_A, WS_VA = WS_KA + SZ_A;
constexpr size_t WS_SAZ = WS_VA + SZ_A;
constexpr size_t WS_QB = WS_SAZ + (size_t)MT * 512 * 2;
constexpr size_t WS_KB = WS_QB + (size_t)MT * 512 * 2;
constexpr size_t WS_VB = WS_KB + (size_t)MT * 128 * 2;
constexpr size_t WS_SBZ = WS_VB + (size_t)MT * 128 * 2;
constexpr size_t WS_END = WS_SBZ + (size_t)MT * 512 * 2;
constexpr size_t WS_G = WS_QA;
constexpr size_t WS_MG = WS_VA;
static_assert((size_t)MT * 2048 * 2 <= 2 * SZ_A && (size_t)MT * 1024 * 2 <= SZ_A, "overlays");
static_assert(WS_END <= (size_t)536870912, "d_ws map must fit 4x the largest tensor");

namespace pg8 {
#define PG8_LAS __attribute__((address_space(3)))
typedef unsigned short bf16_t;
typedef short bf16x8 __attribute__((ext_vector_type(8)));
typedef float f32x4 __attribute__((ext_vector_type(4)));
typedef unsigned u32x4 __attribute__((ext_vector_type(4)));
constexpr int BM = 256, BK = 64, HALF = 128, HTB = HALF * BK * 2  , STAGE_BYTES = 8 * HTB, NXCD = 8, WGM = 8;

__host__ __device__ __forceinline__ int lds_byte(int r, int c) { const int st = (r >> 4) * 2 + (c >> 5), rr = r & 15, cc = c & 31, ob = rr * 64 + cc * 2; return st * 1024 + (ob ^ (((ob >> 9) & 1) << 5)); }
__host__ __device__ __forceinline__ void stage_rc(int b, int& R, int& C) { const int st = b / 1024, sb = b % 1024, swz = sb ^ (((sb >> 9) & 1) << 5); R = (st >> 1) * 16 + swz / 64; C = (st & 1) * 32 + (swz % 64) / 2; }
__host__ __device__ __forceinline__ int perm32(int rho) { const int n = rho >> 4, i = rho & 15; return 8 * (i >> 2) + 4 * n + (i & 3); }

struct Unit { int pm, pn; };
struct Gemm { const bf16_t* A; const bf16_t* Bt; int M, N, K; };

struct StaticOrder {
    int nM, nN, nwg, G, c;
    __host__ __device__ void init(int M, int N, int G_, int c_) { nM = M / BM; nN = N / BM; nwg = nM * nN; G = G_; c = c_; }
    __host__ __device__ bool next(int i, Unit& u) const {
        const long L = (long)i * G + c; if (L >= nwg) return false;
        int wgid = (int)L; { const int q = nwg / NXCD, r = nwg % NXCD, xcd = wgid % NXCD, off = wgid / NXCD; wgid = (xcd < r ? xcd * (q + 1) : r * (q + 1) + (xcd - r) * q) + off; }
        const int nig = WGM * nN, gid = wgid / nig, fm = gid * WGM, gsz = (nM - fm) < WGM ? (nM - fm) : WGM;
        u.pm = fm + ((wgid % nig) % gsz); u.pn = (wgid % nig) / gsz; return true;
    }
    __device__ __forceinline__ void a_ready(const Unit&) const {}
    __device__ __forceinline__ void done(const Unit&) const {}
};

typedef __bf16 bf16x2_c __attribute__((ext_vector_type(2)));
typedef float f32x2_c __attribute__((ext_vector_type(2)));
__device__ __forceinline__ unsigned cvt_pk_bf16(float lo, float hi) { f32x2_c v = {lo, hi}; bf16x2_c b = __builtin_convertvector(v, bf16x2_c); return __builtin_bit_cast(unsigned, b); }
typedef unsigned long long u64_t;
typedef float f32x2e __attribute__((ext_vector_type(2)));
__device__ __forceinline__ u32x4 pack8(const f32x4& a, const f32x4& b) { u32x4 w; w.x = cvt_pk_bf16(a[0], a[1]); w.y = cvt_pk_bf16(a[2], a[3]); w.z = cvt_pk_bf16(b[0], b[1]); w.w = cvt_pk_bf16(b[2], b[3]); return w; }
__device__ __forceinline__ float bf_lo(unsigned u) { return __uint_as_float(u << 16); }
__device__ __forceinline__ float bf_hi(unsigned u) { return __uint_as_float(u & 0xffff0000u); }
__device__ __forceinline__ float fast_sigmoid(float x) { return __builtin_amdgcn_rcpf(1.0f + __builtin_amdgcn_exp2f(-1.44269504089f * x)); }

struct Epi1 {
    static constexpr bool PERM = false, AFTER_DRAIN = false;
    unsigned char* ws;
    const float *qg, *kg; const float* rope;
    bf16_t* Gd; const float* bgate;
    __device__ __forceinline__ void operator()(const f32x4 (&acc)[2][2][4][2], const Unit& u, int wr, int wc, int fr, int fq) const {
        const int T = u.pn;
        const int row0 = u.pm * BM + wr * 64 + fr;
        if (T < 18) {
            const int rg = T / 6, t6 = T - 6 * rg, g = t6 >> 1, lg = 2 * g;
            bf16_t* base = (bf16_t*)(ws + WS_QA + (size_t)rg * SZ_A);
#pragma unroll
            for (int ai = 0; ai < 2; ++ai)
#pragma unroll
                for (int m = 0; m < 4; ++m) {
                    const int row = row0 + ai * HALF + m * 16, b = row >> 13, s = row & 8191;
                    const int p = ((s & ((1 << lg) - 1)) << (13 - lg)) | (s >> lg);
#pragma unroll
                    for (int bj = 0; bj < 2; ++bj) {
                        const int head = (t6 & 1) * 4 + 2 * bj + (wc >> 1), hc0 = 32 * (wc & 1) + 8 * fq;
                        bf16_t* dst = base + ((size_t)(((b * 3 + g) * 8 + head) * 8192 + p) * 64 + hc0);
                        *(u32x4*)dst = pack8(acc[ai][bj][m][0], acc[ai][bj][m][1]);
                    }
                }
        } else if (T >= 25) {
            const int col0 = (T - 25) * BM + 32 * wc + 8 * fq;
            f32x4 bv[2][2];
#pragma unroll
            for (int bj = 0; bj < 2; ++bj)
#pragma unroll
                for (int n = 0; n < 2; ++n) bv[bj][n] = *(const f32x4*)(bgate + col0 + 128 * bj + 4 * n);
#pragma unroll
            for (int ai = 0; ai < 2; ++ai)
#pragma unroll
                for (int m = 0; m < 4; ++m) {
                    const int row = row0 + ai * HALF + m * 16;
#pragma unroll
                    for (int bj = 0; bj < 2; ++bj) {
                        f32x4 a = acc[ai][bj][m][0] + bv[bj][0], c = acc[ai][bj][m][1] + bv[bj][1];
#pragma unroll
                        for (int j = 0; j < 4; ++j) { a[j] = fast_sigmoid(a[j]); c[j] = fast_sigmoid(c[j]); }
                        *(u32x4*)(Gd + (size_t)row * 2048 + col0 + 128 * bj) = pack8(a, c);
                    }
                }
        } else if (T < 20 || T >= 23) {
            bf16_t* out = (bf16_t*)(ws + (T < 20 ? WS_SAZ : WS_SBZ)); const int ct = T < 20 ? T - 18 : T - 23;
#pragma unroll
            for (int ai = 0; ai < 2; ++ai)
#pragma unroll
                for (int m = 0; m < 4; ++m) {
                    const int row = row0 + ai * HALF + m * 16;
#pragma unroll
                    for (int bj = 0; bj < 2; ++bj) {
                        f32x4 a = acc[ai][bj][m][0], c = acc[ai][bj][m][1];
#pragma unroll
                        for (int j = 0; j < 4; ++j) { a[j] = a[j] * fast_sigmoid(a[j]); c[j] = c[j] * fast_sigmoid(c[j]); }
                        *(u32x4*)(out + (size_t)row * 512 + ct * 256 + 128 * bj + 32 * wc + 8 * fq) = pack8(a, c);
                    }
                }
        } else if (T == 22 && wc >= 2) {
            const int head = wc - 2;
#pragma unroll
            for (int ai = 0; ai < 2; ++ai)
#pragma unroll
                for (int m = 0; m < 4; ++m) {
                    const int row = row0 + ai * HALF + m * 16, b = row >> 13, s = row & 8191;
#pragma unroll
                    for (int bj = 0; bj < 2; ++bj)
                        *(u32x4*)((bf16_t*)(ws + WS_VB) + ((size_t)((b * 2 + head) * 8192 + s) * 64 + 32 * bj + 8 * fq)) = pack8(acc[ai][bj][m][0], acc[ai][bj][m][1]);
                }
        } else {
            const bool isk = (T == 22);
            const int head = isk ? wc : (T - 20) * 4 + wc, nH = isk ? 2 : 8;
            bf16_t* dst = (bf16_t*)(ws + (isk ? WS_KB : WS_QB)); const float* gv = isk ? kg : qg;
            f32x4 gq[2][2];
#pragma unroll
            for (int bj = 0; bj < 2; ++bj)
#pragma unroll
                for (int n = 0; n < 2; ++n) gq[bj][n] = *(const f32x4*)(gv + 16 * (2 * bj + n) + 4 * fq);
#pragma unroll
            for (int ai = 0; ai < 2; ++ai)
#pragma unroll
                for (int m = 0; m < 4; ++m) {
                    const int row = row0 + ai * HALF + m * 16, b = row >> 13, s = row & 8191;
                    float ss = 0.f;
#pragma unroll
                    for (int bj = 0; bj < 2; ++bj)
#pragma unroll
                        for (int n = 0; n < 2; ++n) { const f32x4 v = acc[ai][bj][m][n]; ss += (v[0] * v[0] + v[1] * v[1]) + (v[2] * v[2] + v[3] * v[3]); }
                    ss += __shfl_xor(ss, 16); ss += __shfl_xor(ss, 32);
                    const float r = 1.0f / sqrtf(ss * (1.0f / 64.0f) + 1e-6f);
                    bf16_t* drow = dst + ((size_t)((b * nH + head) * 8192 + s) * 64 + 4 * fq);
#pragma unroll
                    for (int bj = 0; bj < 2; ++bj) {
                        const int pos = bj == 0 ? (s >> 6) : (s & 63);
                        const f32x4 cs0 = *(const f32x4*)(rope + (pos * 16 + 4 * fq) * 2), cs1 = *(const f32x4*)(rope + (pos * 16 + 4 * fq) * 2 + 4);
                        const f32x4 cc = {cs0[0], cs0[2], cs1[0], cs1[2]}, sn = {cs0[1], cs0[3], cs1[1], cs1[3]};
                        f32x4 x1 = acc[ai][bj][m][0] * r * gq[bj][0], x2 = acc[ai][bj][m][1] * r * gq[bj][1], o1, o2;
#pragma unroll
                        for (int j = 0; j < 4; ++j) { o1[j] = x1[j] * cc[j] - x2[j] * sn[j]; o2[j] = x2[j] * cc[j] + x1[j] * sn[j]; }
                        u64_t w1 = (u64_t)cvt_pk_bf16(o1[0], o1[1]) | ((u64_t)cvt_pk_bf16(o1[2], o1[3]) << 32);
                        u64_t w2 = (u64_t)cvt_pk_bf16(o2[0], o2[1]) | ((u64_t)cvt_pk_bf16(o2[2], o2[3]) << 32);
                        *(u64_t*)(drow + 16 * (2 * bj)) = w1; *(u64_t*)(drow + 16 * (2 * bj + 1)) = w2;
                    }
                }
        }
    }
};

struct EpiGate {
    static constexpr bool PERM = false, AFTER_DRAIN = false;
    bf16_t* G; const float* bias;
    __device__ __forceinline__ void operator()(const f32x4 (&acc)[2][2][4][2], const Unit& u, int wr, int wc, int fr, int fq) const {
        const int row0 = u.pm * BM + wr * 64 + fr, col0 = u.pn * BM + 32 * wc + 8 * fq;
        f32x4 bv[2][2];
#pragma unroll
        for (int bj = 0; bj < 2; ++bj)
#pragma unroll
            for (int n = 0; n < 2; ++n) bv[bj][n] = *(const f32x4*)(bias + col0 + 128 * bj + 4 * n);
#pragma unroll
        for (int ai = 0; ai < 2; ++ai)
#pragma unroll
            for (int m = 0; m < 4; ++m) {
                const int row = row0 + ai * HALF + m * 16;
#pragma unroll
                for (int bj = 0; bj < 2; ++bj) {
                    f32x4 a = acc[ai][bj][m][0] + bv[bj][0], c = acc[ai][bj][m][1] + bv[bj][1];
#pragma unroll
                    for (int j = 0; j < 4; ++j) { a[j] = fast_sigmoid(a[j]); c[j] = fast_sigmoid(c[j]); }
                    *(u32x4*)(G + (size_t)row * 2048 + col0 + 128 * bj) = pack8(a, c);
                }
            }
    }
};

template <bool ADD> struct EpiMerge {
    static constexpr bool PERM = false, AFTER_DRAIN = false;
    bf16_t* MG; const bf16_t* G; int goff;
    __device__ __forceinline__ void operator()(const f32x4 (&acc)[2][2][4][2], const Unit& u, int wr, int wc, int fr, int fq) const {
        const int row0 = u.pm * BM + wr * 64 + fr, col0 = u.pn * BM + 32 * wc + 8 * fq;
#pragma unroll
        for (int ai = 0; ai < 2; ++ai) {
            u32x4 gw[4][2], ow[4][2];
#pragma unroll
            for (int m = 0; m < 4; ++m)
#pragma unroll
                for (int bj = 0; bj < 2; ++bj) { const int row = row0 + ai * HALF + m * 16;
                    gw[m][bj] = *(const u32x4*)(G + (size_t)row * 2048 + goff + col0 + 128 * bj);
                    if (ADD) ow[m][bj] = *(const u32x4*)(MG + (size_t)row * 1024 + col0 + 128 * bj); }
#pragma unroll
            for (int m = 0; m < 4; ++m)
#pragma unroll
                for (int bj = 0; bj < 2; ++bj) { const int row = row0 + ai * HALF + m * 16;
                    const u32x4 g4 = gw[m][bj];
                    f32x4 a = acc[ai][bj][m][0], c = acc[ai][bj][m][1];
                    a[0] *= bf_lo(g4.x); a[1] *= bf_hi(g4.x); a[2] *= bf_lo(g4.y); a[3] *= bf_hi(g4.y);
                    c[0] *= bf_lo(g4.z); c[1] *= bf_hi(g4.z); c[2] *= bf_lo(g4.w); c[3] *= bf_hi(g4.w);
                    if (ADD) { const u32x4 o4 = ow[m][bj];
                        a[0] += bf_lo(o4.x); a[1] += bf_hi(o4.x); a[2] += bf_lo(o4.y); a[3] += bf_hi(o4.y);
                        c[0] += bf_lo(o4.z); c[1] += bf_hi(o4.z); c[2] += bf_lo(o4.w); c[3] += bf_hi(o4.w); }
                    *(u32x4*)(MG + (size_t)row * 1024 + col0 + 128 * bj) = pack8(a, c);
                }
        }
    }
};

struct EpiOut {
    static constexpr bool PERM = false, AFTER_DRAIN = false;
    const float* xin; float* pre; const float* gate; float alpha;
    __device__ __forceinline__ void operator()(const f32x4 (&acc)[2][2][4][2], const Unit& u, int wr, int wc, int fr, int fq) const {
        const int row0 = u.pm * BM + wr * 64 + fr, col0 = u.pn * BM + 32 * wc + 8 * fq;
        const int b = (u.pm * BM) >> 13;
        f32x4 gv[2][2];
#pragma unroll
        for (int bj = 0; bj < 2; ++bj)
#pragma unroll
            for (int n = 0; n < 2; ++n) gv[bj][n] = *(const f32x4*)(gate + b * 3072 + col0 + 128 * bj + 4 * n);
#pragma unroll
        for (int ai = 0; ai < 2; ++ai) {
            f32x4 xv[4][2][2];
#pragma unroll
            for (int m = 0; m < 4; ++m) { const size_t off = (size_t)(row0 + ai * HALF + m * 16) * 1024 + col0;
#pragma unroll
                for (int bj = 0; bj < 2; ++bj)
#pragma unroll
                    for (int n = 0; n < 2; ++n) xv[m][bj][n] = *(const f32x4*)(xin + off + 128 * bj + 4 * n); }
#pragma unroll
            for (int m = 0; m < 4; ++m) { const size_t off = (size_t)(row0 + ai * HALF + m * 16) * 1024 + col0;
#pragma unroll
                for (int bj = 0; bj < 2; ++bj)
#pragma unroll
                    for (int n = 0; n < 2; ++n) *(f32x4*)(pre + off + 128 * bj + 4 * n) = xv[m][bj][n] * alpha + gv[bj][n] * acc[ai][bj][m][n]; }
        }
    }
};

struct GateOrder {
    StaticOrder S;
    __host__ __device__ void init(int M, int G_, int c_) { S.init(M, 1024, G_, c_); }
    __host__ __device__ bool next(int i, Unit& u) const { Unit m; if (!S.next(i >> 1, m)) return false; u.pm = m.pm; u.pn = m.pn + 4 * (i & 1); return true; }
    __device__ __forceinline__ void a_ready(const Unit&) const {}
    __device__ __forceinline__ void done(const Unit&) const {}
};

struct MergeOrder {
    StaticOrder S; int dpm, dpn;
    __host__ __device__ void init(int M, int G_, int c_, int dpm_, int dpn_) { S.init(M, 1024, G_, c_); dpm = dpm_; dpn = dpn_; }
    __host__ __device__ bool next(int i, Unit& u) const { Unit m; if (!S.next(i >> 1, m)) return false; u.pm = m.pm + (i & 1) * dpm; u.pn = m.pn + (i & 1) * dpn; return true; }
    __device__ __forceinline__ void a_ready(const Unit&) const {}
    __device__ __forceinline__ void done(const Unit&) const {}
};
struct EpiMerge2 {
    static constexpr bool PERM = false, AFTER_DRAIN = false;
    bf16_t* MG; const bf16_t* G; int dpm, dpn;
    __device__ __forceinline__ void operator()(const f32x4 (&acc)[2][2][4][2], const Unit& u, int wr, int wc, int fr, int fq) const {
        const bool pb = u.pm >= dpm; Unit r; r.pm = pb ? u.pm - dpm : u.pm; r.pn = pb ? u.pn - dpn : u.pn;
        if (pb) { EpiMerge<true> E{MG, G, 1024}; E(acc, r, wr, wc, fr, fq); } else { EpiMerge<false> E{MG, G, 0}; E(acc, r, wr, wc, fr, fq); }
    }
};
template <class Epi, class Sched, bool ALIGN_EPI = false, bool SP2 = false>
__device__ __forceinline__ void gemm_phase(PG8_LAS unsigned char* lds, const Gemm g, const Sched& S, const Epi& E) {
    int tid_l = threadIdx.x; asm volatile("" : "+v"(tid_l));
    const int tid = tid_l, wid = __builtin_amdgcn_readfirstlane(tid >> 6), lane = tid & 63, wr = wid >> 2, wc = wid & 3, fr = lane & 15, fq = lane >> 4;
    const int K = g.K, nt = K / BK;
    unsigned voffA[2], voffB[2];
#pragma unroll
    for (int i = 0; i < 2; ++i) { int R, C; stage_rc(tid * 16 + i * 8192, R, C); const int Rb = Epi::PERM ? ((R & ~31) + perm32(R & 31)) : R;
        voffA[i] = (unsigned)(R * K + C) * 2u; voffB[i] = (unsigned)(Rb * K + C) * 2u; }
    const size_t kstep = (size_t)(BK * 2);
    const size_t hstep = (size_t)HALF * K * 2;
    const size_t tstep = 2 * hstep;
    const unsigned ldsw = (unsigned)wid * 1024u;
    const int aoff = lds_byte(wr * 64 + fr, fq * 8), boff = lds_byte(wc * 32 + fr, fq * 8);
#define PG8_SA(b, h) (((b) * 2 + (h)) * HTB)
#define PG8_SB(b, h) ((4 + (b) * 2 + (h)) * HTB)
#define PG8_STAGE(bufoff, gbase, voff) do { _Pragma("unroll") for (int _i = 0; _i < 2; ++_i) \
        __builtin_amdgcn_global_load_lds((const unsigned*)((const char*)(gbase) + (voff)[_i]), (PG8_LAS unsigned*)(lds + (bufoff) + ldsw + _i * 8192), 16, 0, 0); } while (0)
#define PG8_LDA(dst, b, h) do { _Pragma("unroll") for (int m = 0; m < 4; ++m) _Pragma("unroll") for (int k = 0; k < 2; ++k) dst[m][k] = *(const PG8_LAS bf16x8*)(lds + PG8_SA(b, h) + aoff + m * 2048 + k * 1024); } while (0)
#define PG8_LDB(dst, b, h) do { _Pragma("unroll") for (int n = 0; n < 2; ++n) _Pragma("unroll") for (int k = 0; k < 2; ++k) dst[n][k] = *(const PG8_LAS bf16x8*)(lds + PG8_SB(b, h) + boff + n * 2048 + k * 1024); } while (0)
#define PG8_MMA(ai, bj, At, Bt) do { __builtin_amdgcn_s_setprio(1); _Pragma("unroll") for (int m = 0; m < 4; ++m) _Pragma("unroll") for (int n = 0; n < 2; ++n) _Pragma("unroll") for (int k = 0; k < 2; ++k) \
        acc[ai][bj][m][n] = __builtin_amdgcn_mfma_f32_16x16x32_bf16(Bt[n][k], At[m][k], acc[ai][bj][m][n], 0, 0, 0); __builtin_amdgcn_s_setprio(0); } while (0)
#define PG8_WAIT_V(n) asm volatile("s_waitcnt vmcnt(" #n ")" ::: "memory")
#define PG8_WAIT_L(n) asm volatile("s_waitcnt lgkmcnt(" #n ")" ::: "memory")
#define PG8_BAR __builtin_amdgcn_s_barrier()
#define PG8_SCHED __builtin_amdgcn_sched_barrier(0)
    Unit cur, nxt; int ui = 0;
    if (!S.next(0, cur)) return;
    f32x4 acc[2][2][4][2];
#pragma unroll
    for (int a = 0; a < 2; ++a)
#pragma unroll
        for (int b = 0; b < 2; ++b)
#pragma unroll
            for (int m = 0; m < 4; ++m)
#pragma unroll
                for (int n = 0; n < 2; ++n) acc[a][b][m][n] = (f32x4){0.f, 0.f, 0.f, 0.f};
    bf16x8 At[4][2], B0[2][2], B1[2][2];
    const char* cA = (const char*)g.A + (size_t)cur.pm * tstep; const char* cB = (const char*)g.Bt + (size_t)cur.pn * tstep;
    S.a_ready(cur);
    if constexpr (SP2) {
        PG8_STAGE(PG8_SB(0, 0), cB, voffB); PG8_STAGE(PG8_SB(0, 1), cB + hstep, voffB); PG8_STAGE(PG8_SA(0, 0), cA, voffA); PG8_STAGE(PG8_SA(0, 1), cA + hstep, voffA);
        if (wr == 1) PG8_BAR;
        PG8_WAIT_V(2); PG8_BAR;
        PG8_STAGE(PG8_SB(1, 0), cB + kstep, voffB); PG8_STAGE(PG8_SA(1, 0), cA + kstep, voffA); PG8_STAGE(PG8_SB(1, 1), cB + hstep + kstep, voffB);
        PG8_WAIT_V(6); PG8_BAR;
    } else {
        PG8_STAGE(PG8_SB(0, 0), cB, voffB); PG8_STAGE(PG8_SA(0, 0), cA, voffA); PG8_STAGE(PG8_SB(0, 1), cB + hstep, voffB); PG8_STAGE(PG8_SA(0, 1), cA + hstep, voffA);
        if (wr == 1) PG8_BAR;
        PG8_WAIT_V(4); PG8_BAR;
        PG8_STAGE(PG8_SB(1, 0), cB + kstep, voffB); PG8_STAGE(PG8_SA(1, 0), cA + kstep, voffA); PG8_STAGE(PG8_SB(1, 1), cB + hstep + kstep, voffB);
        PG8_WAIT_V(6); PG8_BAR;
    }
    for (;;) {
        const bool has_next = S.next(ui + 1, nxt);
        const char* nA = has_next ? (const char*)g.A + (size_t)nxt.pm * tstep : cA; const char* nB = has_next ? (const char*)g.Bt + (size_t)nxt.pn * tstep : cB;
        for (int t = 0; t < nt; t += 2) {
            const bool last = (t == nt - 2);
            const char* a1 = cA + (size_t)(t + 1) * kstep;
            const char* a2 = last ? nA : cA + (size_t)(t + 2) * kstep; const char* b2 = last ? nB : cB + (size_t)(t + 2) * kstep;
            const char* a3 = a2 + kstep; const char* b3 = b2 + kstep;
            if (last && has_next) S.a_ready(nxt);
            if constexpr (SP2) {
            PG8_LDB(B0, 0, 0); PG8_LDB(B1, 0, 1); PG8_SCHED; PG8_LDA(At, 0, 0); PG8_STAGE(PG8_SA(1, 1), a1 + hstep, voffA);
            PG8_WAIT_V(8); PG8_WAIT_L(0); PG8_BAR; PG8_MMA(0, 0, At, B0); PG8_MMA(0, 1, At, B1); PG8_BAR; PG8_SCHED;
            PG8_LDA(At, 0, 1); PG8_STAGE(PG8_SB(0, 0), b2, voffB); PG8_STAGE(PG8_SB(0, 1), b2 + hstep, voffB); PG8_STAGE(PG8_SA(0, 0), a2, voffA);
            PG8_WAIT_V(8); PG8_WAIT_L(0); PG8_BAR; PG8_MMA(1, 0, At, B0); PG8_MMA(1, 1, At, B1); PG8_BAR; PG8_SCHED;
            PG8_LDB(B0, 1, 0); PG8_LDB(B1, 1, 1); PG8_SCHED; PG8_LDA(At, 1, 0); PG8_STAGE(PG8_SA(0, 1), a2 + hstep, voffA);
            PG8_WAIT_V(8); PG8_WAIT_L(0); PG8_BAR; PG8_MMA(0, 0, At, B0); PG8_MMA(0, 1, At, B1); PG8_BAR; PG8_SCHED;
            PG8_LDA(At, 1, 1); PG8_STAGE(PG8_SB(1, 0), b3, voffB); PG8_STAGE(PG8_SB(1, 1), b3 + hstep, voffB); PG8_STAGE(PG8_SA(1, 0), a3, voffA);
            PG8_WAIT_V(8); PG8_WAIT_L(0); PG8_BAR; PG8_MMA(1, 0, At, B0); PG8_MMA(1, 1, At, B1); PG8_BAR; PG8_SCHED;
            } else {
            PG8_LDB(B0, 0, 0); PG8_SCHED; PG8_LDA(At, 0, 0); PG8_STAGE(PG8_SA(1, 1), a1 + hstep, voffA);
            PG8_WAIT_L(8); PG8_BAR; PG8_WAIT_L(0); PG8_MMA(0, 0, At, B0); PG8_BAR; PG8_SCHED;
            PG8_LDB(B1, 0, 1); PG8_STAGE(PG8_SB(0, 0), b2, voffB);
            PG8_BAR; PG8_WAIT_L(0); PG8_MMA(0, 1, At, B1); PG8_BAR;
            PG8_LDA(At, 0, 1); PG8_STAGE(PG8_SA(0, 0), a2, voffA);
            PG8_BAR; PG8_WAIT_L(0); PG8_MMA(1, 0, At, B0); PG8_BAR; PG8_SCHED;
            PG8_STAGE(PG8_SB(0, 1), b2 + hstep, voffB);
            PG8_WAIT_V(6); PG8_BAR; PG8_MMA(1, 1, At, B1); PG8_BAR;
            PG8_LDB(B0, 1, 0); PG8_SCHED; PG8_LDA(At, 1, 0); PG8_STAGE(PG8_SA(0, 1), a2 + hstep, voffA);
            PG8_WAIT_L(8); PG8_BAR; PG8_WAIT_L(0); PG8_MMA(0, 0, At, B0); PG8_BAR; PG8_SCHED;
            PG8_LDB(B1, 1, 1); PG8_STAGE(PG8_SB(1, 0), b3, voffB);
            PG8_BAR; PG8_WAIT_L(0); PG8_MMA(0, 1, At, B1); PG8_BAR;
            PG8_LDA(At, 1, 1); PG8_STAGE(PG8_SA(1, 0), a3, voffA);
            PG8_BAR; PG8_WAIT_L(0); PG8_MMA(1, 0, At, B0); PG8_BAR; PG8_SCHED;
            PG8_STAGE(PG8_SB(1, 1), b3 + hstep, voffB);
            PG8_WAIT_V(6); PG8_BAR; PG8_MMA(1, 1, At, B1); PG8_BAR;
            }
        }
        if constexpr (ALIGN_EPI) { if (wr == 0) PG8_BAR; }
        if constexpr (!Epi::AFTER_DRAIN) { E(acc, cur, wr, wc, fr, fq); S.done(cur); }
        if (!has_next) break;
#pragma unroll
        for (int a = 0; a < 2; ++a)
#pragma unroll
            for (int b = 0; b < 2; ++b)
#pragma unroll
                for (int m = 0; m < 4; ++m)
#pragma unroll
                    for (int n = 0; n < 2; ++n) acc[a][b][m][n] = (f32x4){0.f, 0.f, 0.f, 0.f};
        cur = nxt; cA = nA; cB = nB; ++ui;
        if constexpr (ALIGN_EPI) { if (wr == 1) PG8_BAR; }
    }
    PG8_WAIT_V(0);
    if constexpr (!ALIGN_EPI) { if (wr == 0) PG8_BAR; }
    PG8_BAR;
    if constexpr (Epi::AFTER_DRAIN) { E.fused(acc, cur, wr, wc, fr, fq, lds, wid, lane); S.done(cur); }
#undef PG8_SA
#undef PG8_SB
#undef PG8_STAGE
#undef PG8_LDA
#undef PG8_LDB
#undef PG8_MMA
#undef PG8_WAIT_V
#undef PG8_WAIT_L
#undef PG8_BAR
#undef PG8_SCHED
}
}

#define LAS __attribute__((address_space(3)))
typedef unsigned short bf16;
typedef float f32x4 __attribute__((ext_vector_type(4)));
typedef float f32x16 __attribute__((ext_vector_type(16)));
typedef short bf16x8 __attribute__((ext_vector_type(8)));
typedef short s16x4 __attribute__((ext_vector_type(4)));
typedef unsigned u32x4 __attribute__((ext_vector_type(4)));
typedef unsigned u32x2 __attribute__((ext_vector_type(2)));
typedef unsigned long long u64;
#define MFMA32(a, b, c) __builtin_amdgcn_mfma_f32_32x32x16_bf16((a), (b), (c), 0, 0, 0)

struct Args {
    const float *x, *c, *rel, *ln_g, *ln_b, *w_ada, *b_ada, *w_in, *b_gate, *qng, *kng, *w_pa, *w_pb, *w_o;
    float* out; unsigned char* ws; int ph_lo, ph_hi, coop, pad;
};

typedef __bf16 bf16x2_t __attribute__((ext_vector_type(2)));
typedef float f32x2_t __attribute__((ext_vector_type(2)));
__device__ __forceinline__ unsigned cvtpk(float lo, float hi) { f32x2_t v = {lo, hi}; bf16x2_t b = __builtin_convertvector(v, bf16x2_t); return __builtin_bit_cast(unsigned, b); }
__device__ __forceinline__ int tid_fresh() { int t = threadIdx.x; asm volatile("" : "+v"(t)); return t; }
__device__ __forceinline__ float bflo(unsigned u) { return __uint_as_float(u << 16); }
__device__ __forceinline__ float bfhi(unsigned u) { return __uint_as_float(u & 0xffff0000u); }
__device__ __forceinline__ float wave_sum(float v) {
#pragma unroll
    for (int o = 1; o < 64; o <<= 1) v += __shfl_xor(v, o);
    return v;
}
__device__ __forceinline__ bf16x8 pack_frag(const f32x16& x, int s) {
    u32x4 p; p.x = cvtpk(x[8 * s], x[8 * s + 1]); p.y = cvtpk(x[8 * s + 2], x[8 * s + 3]); p.z = cvtpk(x[8 * s + 4], x[8 * s + 5]); p.w = cvtpk(x[8 * s + 6], x[8 * s + 7]);
    return __builtin_bit_cast(bf16x8, p);
}
__device__ __forceinline__ int crow(int i, int h) { return (i & 3) + 8 * (i >> 2) + 4 * h; }

__device__ __forceinline__ int slot_src(int kind, int tc) {
    const int bj = tc >> 7, wc = (tc >> 5) & 3, n = (tc >> 4) & 1, fq = (tc >> 2) & 3, j = tc & 3;
    const int plain = 128 * bj + 32 * wc + 8 * fq + 4 * n + j;
    const int ropec = 64 * wc + 16 * (2 * bj + n) + 4 * fq + j;
    const int vcol = 64 * wc + 32 * bj + 8 * fq + 4 * n + j;
    if (kind == 0) return plain;
    if (kind == 1) return ropec;
    return wc < 2 ? ropec : vcol;
}
__device__ __forceinline__ void transpose_item(LAS float* scr, const float* W, int K, int Nsrc, int c0, int k0, bf16* Bt, int n0, int kind) {
    const int tid = tid_fresh();
#pragma unroll 4
    for (int i = 0; i < 8; ++i) {
        const int e = i * 512 + tid, kk = e >> 6, c4 = (e & 63) * 4;
        const f32x4 v = *(const f32x4*)(W + (size_t)(k0 + kk) * Nsrc + c0 + c4);
        LAS float* d = scr + kk * 257 + c4; d[0] = v[0]; d[1] = v[1]; d[2] = v[2]; d[3] = v[3];
    }
    __syncthreads();
    const int tc = tid >> 1, kh = (tid & 1) * 32, sc = slot_src(kind, tc);
    bf16* drow = Bt + (size_t)(n0 + tc) * K + k0 + kh;
#pragma unroll
    for (int q = 0; q < 4; ++q) {
        const LAS float* s = scr + (kh + 8 * q) * 257 + sc;
        u32x4 o; o.x = cvtpk(s[0], s[257]); o.y = cvtpk(s[2 * 257], s[3 * 257]); o.z = cvtpk(s[4 * 257], s[5 * 257]); o.w = cvtpk(s[6 * 257], s[7 * 257]);
        *(u32x4*)(drow + 8 * q) = o;
    }
    __syncthreads();
}

__device__ __forceinline__ int t5_bucket_abs(int a) {
    if (a < 8) return a;
    if (a < 15) return 8; if (a < 27) return 9; if (a < 50) return 10; if (a < 91) return 11; if (a < 166) return 12; if (a < 305) return 13; if (a < 559) return 14; return 15;
}

__device__ __forceinline__ void convert_weights(const Args& A, LAS unsigned char* lds, int l, int first, int stride) {
    unsigned char* ws = A.ws;
    LAS float* scr = (LAS float*)lds;
    constexpr int I1 = 33 * 16, IP = 4 * 8, IO = 4 * 16, NIT = I1 + 2 * IP + IO;
    for (int it = first; it < NIT; it += stride) {
        int r = it;
        if (r < I1) { const int T = r / 16, kt = r % 16;
            const int kind = (T == 20 || T == 21) ? 1 : (T == 22 ? 2 : 0);
            transpose_item(scr, A.w_in + (size_t)l * 1024 * NIN, 1024, NIN, T * 256, kt * 64, (bf16*)(ws + WS_W1T) + (size_t)l * NIN * 1024, T * 256, kind); continue; }
        r -= I1;
        if (r < IP) { const int T = r / 8, kt = r % 8;
            transpose_item(scr, A.w_pa + (size_t)l * 512 * 1024, 512, 1024, T * 256, kt * 64, (bf16*)(ws + WS_WPAT) + (size_t)l * 1024 * 512, T * 256, 0); continue; }
        r -= IP;
        if (r < IP) { const int T = r / 8, kt = r % 8;
            transpose_item(scr, A.w_pb + (size_t)l * 512 * 1024, 512, 1024, T * 256, kt * 64, (bf16*)(ws + WS_WPBT) + (size_t)l * 1024 * 512, T * 256, 0); continue; }
        r -= IP;
        { const int T = r / 16, kt = r % 16;
            transpose_item(scr, A.w_o + (size_t)l * 1024 * 1024, 1024, 1024, T * 256, kt * 64, (bf16*)(ws + WS_WOT) + (size_t)l * 1024 * 1024, T * 256, 0); }
    }
}

__device__ __forceinline__ void p0_prologue(const Args& A, LAS unsigned char* lds) {
    const int tid = tid_fresh(), bx = blockIdx.x, G = gridDim.x;
    unsigned char* ws = A.ws;
    for (int it = bx; it < 96; it += G) {
        LAS float* sc = (LAS float*)lds;
        LAS float* red = sc + 4096;
        for (int e = tid; e < 4096; e += 512) { const float v = A.c[e]; sc[e] = v / (1.0f + __expf(-v)); }
        __syncthreads();
        const int l = it / 48, col = (it % 48) * 64 + (tid & 63), kc = tid >> 6;
        const float* w = A.w_ada + (size_t)l * 1024 * 3072 + col;
        float a0 = 0.f, a1 = 0.f, a2 = 0.f, a3 = 0.f;
#pragma unroll 8
        for (int k = kc * 128; k < kc * 128 + 128; ++k) { const float wv = w[(size_t)k * 3072]; a0 += sc[k] * wv; a1 += sc[1024 + k] * wv; a2 += sc[2048 + k] * wv; a3 += sc[3072 + k] * wv; }
        red[(kc * 4 + 0) * 64 + (tid & 63)] = a0; red[(kc * 4 + 1) * 64 + (tid & 63)] = a1; red[(kc * 4 + 2) * 64 + (tid & 63)] = a2; red[(kc * 4 + 3) * 64 + (tid & 63)] = a3;
        __syncthreads();
        if (tid < 256) { const int b = tid >> 6, cl = tid & 63; float s = 0.f;
#pragma unroll
            for (int q = 0; q < 8; ++q) s += red[(q * 4 + b) * 64 + cl];
            const int cc = (it % 48) * 64 + cl;
            ((float*)(ws + WS_MOD))[(l * 4 + b) * 3072 + cc] = s + A.b_ada[l * 3072 + cc]; }
        __syncthreads();
    }
    if (bx == G - 1) {
        float* rope = (float*)(ws + WS_ROPE);
        for (int e = tid; e < 128 * 16; e += 512) { const int pos = e >> 4, i = e & 15;
            const float inv = powf(10000.0f, -(float)(2 * i) / 32.0f); const float ang = (float)pos * inv;
            rope[2 * e] = cosf(ang); rope[2 * e + 1] = sinf(ang); }
        float* bias = (float*)(ws + WS_BIAS);
        for (int e = tid; e < 3 * 8 * 129; e += 512) { const int g = e / (8 * 129), r = e % (8 * 129), h = r / 129, idx = r % 129;
            const int rel = idx - 64, d = 1 << (2 * g), a = (rel < 0 ? -rel : rel) * d;
            const int bucket = (rel > 0 ? 16 : 0) + t5_bucket_abs(a);
            bias[(g * 8 + h) * 132 + idx] = A.rel[bucket * 24 + g * 8 + h] * LOG2E; }
    }
    convert_weights(A, lds, 0, (bx + 160) % G, G);
}

__device__ __forceinline__ void p_modulate(const Args& A) {
    const float* mod = (const float*)(A.ws + WS_MOD);
    bf16* U = (bf16*)(A.ws + WS_U);
    const size_t n8 = (size_t)MT * 1024 / 8;
    const int tidm = tid_fresh();
    for (size_t e = (size_t)blockIdx.x * 512 + tidm; e < n8; e += (size_t)gridDim.x * 512) {
        const int row = (int)(e >> 7), c8 = (int)(e & 127) * 8, b = row >> 13;
        const f32x4 x0 = *(const f32x4*)(A.x + (size_t)row * 1024 + c8), x1 = *(const f32x4*)(A.x + (size_t)row * 1024 + c8 + 4);
        const float* mb = mod + b * 3072 + c8;
        const f32x4 sh0 = *(const f32x4*)(mb), sh1 = *(const f32x4*)(mb + 4), sc0 = *(const f32x4*)(mb + 1024), sc1 = *(const f32x4*)(mb + 1028);
        const f32x4 u0 = x0 * (sc0 + 1.0f) + sh0, u1 = x1 * (sc1 + 1.0f) + sh1;
        u32x4 o; o.x = cvtpk(u0[0], u0[1]); o.y = cvtpk(u0[2], u0[3]); o.z = cvtpk(u1[0], u1[1]); o.w = cvtpk(u1[2], u1[3]);
        *(u32x4*)(U + (size_t)row * 1024 + c8) = o;
    }
}

__device__ __forceinline__ void p_layernorm(const Args& A, int l) {
    const int tidl = tid_fresh(); const int lane = tidl & 63, gw = blockIdx.x * 8 + (tidl >> 6), NGW = gridDim.x * 8;
    const float* lg = A.ln_g + l * 1024; const float* lb = A.ln_b + l * 1024;
    const float* mod = (const float*)(A.ws + WS_MOD) + (size_t)(l + 1) * 4 * 3072;
    bf16* U = (bf16*)(A.ws + WS_U);
    f32x4 gv[4], bv[4];
#pragma unroll
    for (int j = 0; j < 4; ++j) { gv[j] = *(const f32x4*)(lg + 4 * lane + 256 * j); bv[j] = *(const f32x4*)(lb + 4 * lane + 256 * j); }
    f32x4 vn[4];
#pragma unroll
    for (int j = 0; j < 4; ++j) vn[j] = *(const f32x4*)(A.out + (size_t)gw * 1024 + 4 * lane + 256 * j);
    for (int row = gw; row < MT; row += NGW) {
        float* xr = A.out + (size_t)row * 1024 + 4 * lane;
        f32x4 v[4]; float s = 0.f;
        const int rown = row + NGW < MT ? row + NGW : row;
#pragma unroll
        for (int j = 0; j < 4; ++j) { v[j] = vn[j]; s += (v[j][0] + v[j][1]) + (v[j][2] + v[j][3]); }
#pragma unroll
        for (int j = 0; j < 4; ++j) vn[j] = *(const f32x4*)(A.out + (size_t)rown * 1024 + 4 * lane + 256 * j);
        const float mean = wave_sum(s) * (1.0f / 1024.0f); float s2 = 0.f;
#pragma unroll
        for (int j = 0; j < 4; ++j) { v[j] = v[j] - mean; s2 += (v[j][0] * v[j][0] + v[j][1] * v[j][1]) + (v[j][2] * v[j][2] + v[j][3] * v[j][3]); }
        const float rstd = 1.0f / sqrtf(wave_sum(s2) * (1.0f / 1024.0f) + 1e-5f);
#pragma unroll
        for (int j = 0; j < 4; ++j) { v[j] = v[j] * rstd * gv[j] + bv[j]; *(f32x4*)(xr + 256 * j) = v[j]; }
        if (l + 1 < DEPTH) {
            const float* mb = mod + (row >> 13) * 3072 + 4 * lane;
#pragma unroll
            for (int j = 0; j < 4; ++j) { const f32x4 sh = *(const f32x4*)(mb + 256 * j), sc = *(const f32x4*)(mb + 1024 + 256 * j);
                const f32x4 u = v[j] * (sc + 1.0f) + sh;
                *(u64*)(U + (size_t)row * 1024 + 4 * lane + 256 * j) = (u64)cvtpk(u[0], u[1]) | ((u64)cvtpk(u[2], u[3]) << 32); }
        }
    }
}

constexpr int KST = 144, VST = 192;
typedef short v4i16_b __attribute__((ext_vector_type(4)));
__device__ __forceinline__ s16x4 lds_tr_b(const LAS unsigned char* p) { return __builtin_bit_cast(s16x4, __builtin_amdgcn_ds_read_tr16_b64_v4i16((LAS v4i16_b*)p)); }
constexpr int BUF_B = 64 * KST + 64 * VST;
__device__ __forceinline__ void attnB_unit(LAS unsigned char* lds, const Args& A, int unit, const float* kng, bool do_store = true) {
    const int tid = tid_fresh(), wave = tid >> 6, lane = tid & 63, ql = lane & 31, hh = lane >> 5;
    const int qblk = unit & 31, hq = (unit >> 5) & 7, b = unit >> 8, kvh = hq >> 2;
    const bf16* Qp = (const bf16*)(A.ws + WS_QB) + ((size_t)((b * 8 + hq) * 8192 + qblk * 256 + wave * 32 + ql) * 64);
    bf16x8 qf[4];
#pragma unroll
    for (int s = 0; s < 4; ++s) { const u32x4 qw = *(const u32x4*)(Qp + 16 * s + 8 * hh);
        u32x4 qs; qs.x = cvtpk(bflo(qw.x) * QK_C, bfhi(qw.x) * QK_C); qs.y = cvtpk(bflo(qw.y) * QK_C, bfhi(qw.y) * QK_C); qs.z = cvtpk(bflo(qw.z) * QK_C, bfhi(qw.z) * QK_C); qs.w = cvtpk(bflo(qw.w) * QK_C, bfhi(qw.w) * QK_C);
        qf[s] = __builtin_bit_cast(bf16x8, qs); }
    const int key = tid >> 3, ch = tid & 7;
    const bf16* Kg = (const bf16*)(A.ws + WS_KB) + ((size_t)((b * 2 + kvh) * 8192 + key) * 64 + ch * 8);
    const bf16* Vg = (const bf16*)(A.ws + WS_VB) + ((size_t)((b * 2 + kvh) * 8192 + key) * 64 + ch * 8);
    f32x16 o0, o1;
#pragma unroll
    for (int i = 0; i < 16; ++i) { o0[i] = 0.f; o1[i] = 0.f; }
    float m_used = -1e30f, l = 0.f; float lp[4] = {0.f, 0.f, 0.f, 0.f};
    u32x4 kreg = *(const u32x4*)Kg, vreg = *(const u32x4*)Vg;
    u32x4 kq1 = *(const u32x4*)(Kg + (size_t)64 * 64), vq1 = *(const u32x4*)(Vg + (size_t)64 * 64), kq0 = *(const u32x4*)(Kg + (size_t)2 * 64 * 64), vq0 = *(const u32x4*)(Vg + (size_t)2 * 64 * 64);
#define WRITE_TILE(bufp) do { LAS unsigned char* _k = (bufp); LAS unsigned char* _v = (bufp) + 64 * KST; \
        *(LAS u32x4*)(_k + key * KST + ch * 16) = kreg; \
        *(LAS u32x4*)(_v + key * VST + ch * 16) = vreg; } while (0)
#define QK_TILE(kbp, d0, d1) do { _Pragma("unroll") for (int s = 0; s < 4; ++s) { \
        const bf16x8 _k0 = *(const LAS bf16x8*)((kbp) + ql * KST + hh * 16 + 32 * s), _k1 = *(const LAS bf16x8*)((kbp) + (32 + ql) * KST + hh * 16 + 32 * s); \
        d0 = MFMA32(_k0, qf[s], d0); d1 = MFMA32(_k1, qf[s], d1); } } while (0)
    __syncthreads();
    WRITE_TILE(lds);
    kreg = kq1; vreg = vq1;
    WRITE_TILE(lds + BUF_B);
    __syncthreads();
    constexpr int NT = SEQ / 64;
    f32x16 c0, c1, d0, d1, o2;
#pragma unroll
    for (int i = 0; i < 16; ++i) { c0[i] = 0.f; c1[i] = 0.f; o2[i] = 0.f; }
    QK_TILE(lds, c0, c1);
    float mx = fmaxf(c0[0], c1[0]);
#pragma unroll
    for (int i = 1; i < 16; ++i) mx = fmaxf(mx, fmaxf(c0[i], c1[i]));
    mx = fmaxf(mx, __shfl_xor(mx, 32));
    float qn2 = 0.f;
#pragma unroll
    for (int s = 0; s < 4; ++s) { const u32x4 qw = __builtin_bit_cast(u32x4, qf[s]);
        qn2 += bflo(qw.x) * bflo(qw.x) + bfhi(qw.x) * bfhi(qw.x) + bflo(qw.y) * bflo(qw.y) + bfhi(qw.y) * bfhi(qw.y) + bflo(qw.z) * bflo(qw.z) + bfhi(qw.z) * bfhi(qw.z) + bflo(qw.w) * bflo(qw.w) + bfhi(qw.w) * bfhi(qw.w); }
    qn2 += __shfl_xor(qn2, 32);
    float gk = fabsf(kng[lane]);
#pragma unroll
    for (int o = 1; o < 64; o <<= 1) gk = fmaxf(gk, __shfl_xor(gk, o));
    const bool fast = __all(sqrtf(qn2) * 8.0f * gk * 1.05f <= 48.0f) != 0;
    if (fast) { m_used = 0.f; mx = 0.f; }
    else {
        m_used = mx;
#pragma unroll
        for (int i = 0; i < 16; ++i) { c0[i] -= m_used; c1[i] -= m_used; }
        mx = 0.f;
    }
    const short one_bits = ql == 0 ? (short)0x3F80 : (short)0;
    const bf16x8 ones = {one_bits, one_bits, one_bits, one_bits, one_bits, one_bits, one_bits, one_bits};
    int rb = 0;
#define SB() __builtin_amdgcn_sched_barrier(0)
#define PRI1() do {} while (0)
#define PRI0() do {} while (0)
#define VFRAG(ks, A0, A1) const LAS unsigned char* _vr##ks = vb + (16 * ks + 4 * hh + ((lane & 15) >> 2)) * VST + 32 * ((lane >> 4) & 1) + 8 * (lane & 3); \
        const bf16x8 A0 = __builtin_shufflevector(lds_tr_b(_vr##ks), lds_tr_b(_vr##ks + 8 * VST), 0, 1, 2, 3, 4, 5, 6, 7), A1 = __builtin_shufflevector(lds_tr_b(_vr##ks + 64), lds_tr_b(_vr##ks + 8 * VST + 64), 0, 1, 2, 3, 4, 5, 6, 7)
#define EXP4(C, i0) do { _Pragma("unroll") for (int i = (i0); i < (i0) + 4; ++i) C[i] = __builtin_amdgcn_exp2f(C[i]); } while (0)
#define E2(C, PW, k) do { C[2 * (k)] = __builtin_amdgcn_exp2f(C[2 * (k)]); C[2 * (k) + 1] = __builtin_amdgcn_exp2f(C[2 * (k) + 1]); PW[k] = cvtpk(C[2 * (k)], C[2 * (k) + 1]); lp[(k) & 3] += C[2 * (k)] + C[2 * (k) + 1]; } while (0)
#define PFRAG(PW, h) __builtin_bit_cast(bf16x8, (u32x4){PW[4 * (h)], PW[4 * (h) + 1], PW[4 * (h) + 2], PW[4 * (h) + 3]})
#define SUB4(N, i0) do { N[i0] -= m_used; N[(i0) + 1] -= m_used; N[(i0) + 2] -= m_used; N[(i0) + 3] -= m_used; } while (0)
#define SGB(mask, n) __builtin_amdgcn_sched_group_barrier(mask, n, 0)
#define AB_PIPE() do { SGB(0x020, 2); SGB(0x100, 8); SGB(0x400, 2); SGB(0x002, 1); \
        _Pragma("unroll") for (int _i = 0; _i < 8; ++_i) { SGB(0x008, 1); SGB(0x400, 2); SGB(0x002, 1); SGB(0x100, 1); } \
        _Pragma("unroll") for (int _i = 0; _i < 7; ++_i) { SGB(0x008, 1); SGB(0x400, 2); SGB(0x002, 1); } \
        _Pragma("unroll") for (int _i = 0; _i < 5; ++_i) { SGB(0x008, 1); SGB(0x002, 7); } } while (0)
#define AB_STEP(C0, C1, N0, N1, T, KL, VL, KW, VW, FAST) do { \
        if (!(FAST) && __any(mx > 8.0f)) {     \
            const float inc = fmaxf(mx, 0.f), alpha = __builtin_amdgcn_exp2f(-inc); m_used += inc; l *= alpha; lp[0] *= alpha; lp[1] *= alpha; lp[2] *= alpha; lp[3] *= alpha; \
            _Pragma("unroll") for (int i = 0; i < 16; ++i) { o0[i] *= alpha; o1[i] *= alpha; C0[i] -= inc; C1[i] -= inc; } } \
        const int rb1 = rb == 2 ? 0 : rb + 1, rb2 = rb1 == 2 ? 0 : rb1 + 1; \
        LAS unsigned char* kb1 = lds + rb1 * BUF_B; LAS unsigned char* vb = lds + rb * BUF_B + 64 * KST; \
        const int tn = (T) + 3 < NT ? (T) + 3 : NT - 1;     \
        KL = *(const u32x4*)(Kg + (size_t)tn * 64 * 64); VL = *(const u32x4*)(Vg + (size_t)tn * 64 * 64); \
        _Pragma("unroll") for (int i = 0; i < 16; ++i) { N0[i] = 0.f; N1[i] = 0.f; } \
        bf16x8 kf0[4], kf1[4]; \
        _Pragma("unroll") for (int s = 0; s < 4; ++s) { kf0[s] = *(const LAS bf16x8*)(kb1 + ql * KST + hh * 16 + 32 * s); kf1[s] = *(const LAS bf16x8*)(kb1 + (32 + ql) * KST + hh * 16 + 32 * s); } \
        unsigned pw0[8], pw1[8]; \
        E2(C0, pw0, 0); \
        N0 = MFMA32(kf0[0], qf[0], N0); E2(C0, pw0, 1); \
        N1 = MFMA32(kf1[0], qf[0], N1); E2(C0, pw0, 2); VFRAG(0, va0, vc0); \
        N0 = MFMA32(kf0[1], qf[1], N0); E2(C0, pw0, 3); \
        N1 = MFMA32(kf1[1], qf[1], N1); E2(C0, pw0, 4); VFRAG(1, va1, vc1); \
        N0 = MFMA32(kf0[2], qf[2], N0); E2(C0, pw0, 5); \
        N1 = MFMA32(kf1[2], qf[2], N1); E2(C0, pw0, 6); VFRAG(2, va2, vc2); \
        N0 = MFMA32(kf0[3], qf[3], N0); E2(C0, pw0, 7); \
        N1 = MFMA32(kf1[3], qf[3], N1); E2(C1, pw1, 0); VFRAG(3, va3, vc3); \
        const bf16x8 pf0 = PFRAG(pw0, 0), pf1 = PFRAG(pw0, 1); \
        o0 = MFMA32(va0, pf0, o0); E2(C1, pw1, 1); \
        o1 = MFMA32(vc0, pf0, o1); E2(C1, pw1, 2); \
        E2(C1, pw1, 3); \
        o0 = MFMA32(va1, pf1, o0); E2(C1, pw1, 4); \
        o1 = MFMA32(vc1, pf1, o1); E2(C1, pw1, 5); \
        E2(C1, pw1, 6); \
        const bf16x8 pf2 = PFRAG(pw1, 0); \
        o0 = MFMA32(va2, pf2, o0); E2(C1, pw1, 7); \
        const bf16x8 pf3 = PFRAG(pw1, 1); \
        o1 = MFMA32(vc2, pf2, o1); \
        o0 = MFMA32(va3, pf3, o0); \
        o1 = MFMA32(vc3, pf3, o1); \
        if (!(FAST)) { SUB4(N0, 0); SUB4(N0, 4); SUB4(N0, 8); SUB4(N0, 12); SUB4(N1, 0); SUB4(N1, 4); SUB4(N1, 8); SUB4(N1, 12); \
            float mxn = fmaxf(N0[0], N1[0]); \
            _Pragma("unroll") for (int i = 1; i < 16; ++i) mxn = fmaxf(mxn, fmaxf(N0[i], N1[i])); \
            mx = fmaxf(mxn, __shfl_xor(mxn, 32)); } \
        \
        kreg = KW; vreg = VW; WRITE_TILE(lds + rb2 * BUF_B); \
        asm volatile("s_waitcnt lgkmcnt(0)" ::: "memory"); __builtin_amdgcn_s_barrier(); asm volatile("" ::: "memory");     \
        rb = rb1; } while (0)
    if (fast) {
#pragma unroll 1
        for (int t = 0; t < NT; t += 2) { AB_STEP(c0, c1, d0, d1, t, kq1, vq1, kq0, vq0, true); AB_STEP(d0, d1, c0, c1, t + 1, kq0, vq0, kq1, vq1, true); }
    } else {
#pragma unroll 1
        for (int t = 0; t < NT; t += 2) { AB_STEP(c0, c1, d0, d1, t, kq1, vq1, kq0, vq0, false); AB_STEP(d0, d1, c0, c1, t + 1, kq0, vq0, kq1, vq1, false); }
    }
#undef AB_STEP
#undef AB_PIPE
#undef SGB
#undef SB
#undef PRI1
#undef PRI0
#undef E2
#undef PFRAG
#undef SUB4
#undef VFRAG
#undef EXP4
    l += (lp[0] + lp[1]) + (lp[2] + lp[3]);
    l += __shfl_xor(l, 32);
#undef WRITE_TILE
#undef QK_TILE
    const float inv = 1.0f / l;
    bf16* yrow = (bf16*)(A.ws + WS_SBZ) + ((size_t)(b * 8192 + qblk * 256 + wave * 32 + ql) * 512 + hq * 64 + 4 * hh);
    u32x2 zz[8];
#pragma unroll
    for (int g4 = 0; g4 < 4; ++g4) { zz[g4] = *(const u32x2*)(yrow + 8 * g4); zz[4 + g4] = *(const u32x2*)(yrow + 32 + 8 * g4); }
    if (do_store)
#pragma unroll
    for (int g4 = 0; g4 < 4; ++g4) {
        { bf16* p = yrow + 8 * g4; const u32x2 z = zz[g4];
          u32x2 w; w.x = cvtpk(o0[4 * g4] * inv * bflo(z.x), o0[4 * g4 + 1] * inv * bfhi(z.x)); w.y = cvtpk(o0[4 * g4 + 2] * inv * bflo(z.y), o0[4 * g4 + 3] * inv * bfhi(z.y)); *(u32x2*)p = w; }
        { bf16* p = yrow + 32 + 8 * g4; const u32x2 z = zz[4 + g4];
          u32x2 w; w.x = cvtpk(o1[4 * g4] * inv * bflo(z.x), o1[4 * g4 + 1] * inv * bfhi(z.x)); w.y = cvtpk(o1[4 * g4 + 2] * inv * bflo(z.y), o1[4 * g4 + 3] * inv * bfhi(z.y)); *(u32x2*)p = w; }
    }
}

constexpr int AST = 144;
constexpr int A_BIAS_OFF = 0, A_K_OFF = 4096, A_V_OFF = A_K_OFF + 384 * AST;
static_assert(A_V_OFF + 384 * AST <= LDS_BYTES, "mixer A LDS map");
typedef short v4i16_t __attribute__((ext_vector_type(4)));
__device__ __forceinline__ s16x4 lds_tr(const LAS unsigned char* p) { return __builtin_bit_cast(s16x4, __builtin_amdgcn_ds_read_tr16_b64_v4i16((LAS v4i16_t*)p)); }
__device__ __forceinline__ void attnA_unit(LAS unsigned char* lds, const Args& A, int unit) {
    const int tid = tid_fresh(), wave = tid >> 6, lane = tid & 63, ql = lane & 31, hh = lane >> 5;
    const int c = unit & 7, h = (unit >> 3) & 7, b = unit >> 6;
    LAS float* biasl = (LAS float*)(lds + A_BIAS_OFF);
    LAS unsigned char* kt_l = lds + A_K_OFF; LAS unsigned char* vt_l = lds + A_V_OFF;
    __syncthreads();
    for (int e = tid; e < 3 * 192; e += 512) { const int g = e / 192, idx = e % 192 - 32;
        biasl[e] = (idx >= 0 && idx <= 128) ? ((const float*)(A.ws + WS_BIAS))[(g * 8 + h) * 132 + idx] : -1e30f; }
    float* LSE = (float*)(A.ws + WS_LSE);
    const int srow = tid >> 3, sch = tid & 7;
#pragma unroll 1
    for (int g = 0; g < 3; ++g) {
        const int lg = 2 * g, L = 8192 >> lg, nsb = g == 2 ? 8 : 4;
        const size_t bgh = (size_t)((b * 3 + g) * 8 + h) * 8192;
        bf16* Qg = (bf16*)(A.ws + WS_QA) + bgh * 64; const bf16* Kg = (const bf16*)(A.ws + WS_KA) + bgh * 64; const bf16* Vg = (const bf16*)(A.ws + WS_VA) + bgh * 64;
        const LAS float* bl = biasl + g * 192;
        const bool active = g < 2 || wave < 4;
#define A_GEOM(SB, ROW, PB, KI) do { if (g == 2) { const int _p = (ROW) >= 192 ? 1 : 0; PB = (2 * (SB) + _p) * L; KI = c * 64 - 64 + (ROW) - 192 * _p; } \
            else { PB = (g == 0 ? 0 : (SB)) * L; KI = (g == 0 ? c * 1024 + (SB) * 256 : c * 256) - 64 + (ROW); } } while (0)
#define A_QPOS(SB, PB, I0, RB) do { if (g == 2) { const int _p = wave >> 1; PB = (2 * (SB) + _p) * L; I0 = c * 64 + 32 * (wave & 1); RB = 192 * _p + 32 * (wave & 1); } \
            else { PB = (g == 0 ? 0 : (SB)) * L; I0 = (g == 0 ? c * 1024 + (SB) * 256 : c * 256) + 32 * wave; RB = 32 * wave; } } while (0)
#define A_LOAD(SB) do { _Pragma("unroll") for (int it = 0; it < 6; ++it) { int pb, ki; A_GEOM(SB, it * 64 + srow, pb, ki); ki = ki < 0 ? 0 : (ki > L - 1 ? L - 1 : ki); \
                const size_t off = (size_t)(pb + ki) * 64 + sch * 8; kst[it] = *(const u32x4*)(Kg + off); vst[it] = *(const u32x4*)(Vg + off); } \
            } while (0)
#define A_LOADQ(SB) do { if (active) { int pb, i0, rbq; A_QPOS(SB, pb, i0, rbq); const bf16* qr = Qg + (size_t)(pb + i0 + ql) * 64 + 8 * hh; \
                _Pragma("unroll") for (int s = 0; s < 4; ++s) qf[s] = *(const bf16x8*)(qr + 16 * s); } } while (0)
#define A_STORE() do { _Pragma("unroll") for (int it = 0; it < 6; ++it) { *(LAS u32x4*)(kt_l + (it * 64 + srow) * AST + sch * 16) = kst[it]; *(LAS u32x4*)(vt_l + (it * 64 + srow) * AST + sch * 16) = vst[it]; } } while (0)
        u32x4 kst[6], vst[6]; bf16x8 qf[4];
        A_LOAD(0); A_LOADQ(0);
        __syncthreads();
        A_STORE();
        __syncthreads();
#pragma unroll 1
        for (int sb = 0; sb < nsb; ++sb) {
            if (sb + 1 < nsb) A_LOAD(sb + 1);
            if (active) {
                int pbase, i0, rb; A_QPOS(sb, pbase, i0, rb);
                bf16* Qrow = Qg + (size_t)(pbase + i0 + ql) * 64;
                f32x16 S[5];
#pragma unroll
                for (int kt = 0; kt < 5; ++kt)
#pragma unroll
                    for (int i = 0; i < 16; ++i) S[kt][i] = 0.f;
#pragma unroll
                for (int s = 0; s < 4; ++s)
#pragma unroll
                    for (int kt = 0; kt < 5; ++kt) S[kt] = MFMA32(*(const LAS bf16x8*)(kt_l + (rb + 32 * kt + ql) * AST + hh * 16 + 32 * s), qf[s], S[kt]);
                asm volatile("" : "+v"(S[4][15]));
                if (sb + 1 < nsb) { A_LOADQ(sb + 1); }
                const bool edge = (i0 < 64) || (i0 + 96 > L);
                float mxp[2] = {-1e30f, -1e30f};
#pragma unroll
                for (int kt = 0; kt < 5; ++kt)
#pragma unroll
                    for (int i = 0; i < 16; ++i) {
                        const int cr = crow(i, 0);
                        float v = S[kt][i] * QK_C + bl[32 * kt + cr + 4 * hh - ql + 32];
                        if (edge) { const int kidx = i0 - 64 + 32 * kt + cr + 4 * hh; if (kidx < 0 || kidx >= L) v = -1e30f; }
                        S[kt][i] = v; mxp[i & 1] = fmaxf(mxp[i & 1], v);
                    }
                float mx = fmaxf(mxp[0], mxp[1]);
                mx = fmaxf(mx, __shfl_xor(mx, 32));
                float lsp[2] = {0.f, 0.f};
#pragma unroll
                for (int kt = 0; kt < 5; ++kt)
#pragma unroll
                    for (int i = 0; i < 16; ++i) { const float p = __builtin_amdgcn_exp2f(S[kt][i] - mx); S[kt][i] = p; lsp[i & 1] += p; }
                float ls = lsp[0] + lsp[1];
                ls += __shfl_xor(ls, 32);
                f32x16 o0, o1;
#pragma unroll
                for (int i = 0; i < 16; ++i) { o0[i] = 0.f; o1[i] = 0.f; }
                const LAS unsigned char* vr0 = vt_l + (rb + 4 * hh + ((lane & 15) >> 2)) * AST + 32 * ((lane >> 4) & 1) + 8 * (lane & 3);
#pragma unroll
                for (int kt = 0; kt < 5; ++kt)
#pragma unroll
                    for (int ks = 0; ks < 2; ++ks) {
                        const bf16x8 pf = pack_frag(S[kt], ks);
                        const LAS unsigned char* vr = vr0 + (32 * kt + 16 * ks) * AST;
                        const s16x4 a0 = lds_tr(vr), a1 = lds_tr(vr + 8 * AST), c0 = lds_tr(vr + 64), c1 = lds_tr(vr + 8 * AST + 64);
                        o0 = MFMA32(__builtin_shufflevector(a0, a1, 0, 1, 2, 3, 4, 5, 6, 7), pf, o0);
                        o1 = MFMA32(__builtin_shufflevector(c0, c1, 0, 1, 2, 3, 4, 5, 6, 7), pf, o1);
                    }
                const float inv = 1.0f / ls;
                bf16* orow = Qrow + 4 * hh;
#pragma unroll
                for (int g4 = 0; g4 < 4; ++g4) {
                    u32x2 w; w.x = cvtpk(o0[4 * g4] * inv, o0[4 * g4 + 1] * inv); w.y = cvtpk(o0[4 * g4 + 2] * inv, o0[4 * g4 + 3] * inv); *(u32x2*)(orow + 8 * g4) = w;
                    u32x2 z; z.x = cvtpk(o1[4 * g4] * inv, o1[4 * g4 + 1] * inv); z.y = cvtpk(o1[4 * g4 + 2] * inv, o1[4 * g4 + 3] * inv); *(u32x2*)(orow + 32 + 8 * g4) = z;
                }
                if (hh == 0) LSE[(size_t)((g * 4 + b) * 8 + h) * 8192 + pbase + i0 + ql] = mx + __builtin_amdgcn_logf(ls);
            }
            __syncthreads();
            if (sb + 1 < nsb) { A_STORE(); __syncthreads(); }
        }
#undef A_GEOM
#undef A_QPOS
#undef A_LOAD
#undef A_LOADQ
#undef A_STORE
    }
    __syncthreads();
    bf16* SAZ = (bf16*)(A.ws + WS_SAZ);
#pragma unroll 1
    for (int it0 = 0; it0 < 16; it0 += 4) {
        float ls2[4][3]; u32x4 og[4][3], zv[4];
#pragma unroll
        for (int q = 0; q < 4; ++q) {
            const int e = (it0 + q) * 512 + tid, tl = e >> 3, ch = e & 7, s = c * 1024 + tl;
#pragma unroll
            for (int g = 0; g < 3; ++g) { const int lg = 2 * g, p = ((s & ((1 << lg) - 1)) << (13 - lg)) | (s >> lg);
                ls2[q][g] = LSE[(size_t)((g * 4 + b) * 8 + h) * 8192 + p];
                og[q][g] = *(const u32x4*)((const bf16*)(A.ws + WS_QA) + ((size_t)((b * 3 + g) * 8 + h) * 8192 + p) * 64 + ch * 8); }
            zv[q] = *(const u32x4*)(SAZ + (size_t)(b * 8192 + s) * 512 + h * 64 + ch * 8);
        }
#pragma unroll
        for (int q = 0; q < 4; ++q) {
            const int e = (it0 + q) * 512 + tid, tl = e >> 3, ch = e & 7, s = c * 1024 + tl;
            const float M = fmaxf(ls2[q][0], fmaxf(ls2[q][1], ls2[q][2]));
            float w0 = __builtin_amdgcn_exp2f(ls2[q][0] - M), w1 = __builtin_amdgcn_exp2f(ls2[q][1] - M), w2 = __builtin_amdgcn_exp2f(ls2[q][2] - M);
            const float wi = 1.0f / (w0 + w1 + w2); w0 *= wi; w1 *= wi; w2 *= wi;
            const u32x4 z = zv[q]; u32x4 o;
#define CMB(f) { const float lo = (w0 * bflo(og[q][0].f) + w1 * bflo(og[q][1].f) + w2 * bflo(og[q][2].f)) * bflo(z.f); const float hi = (w0 * bfhi(og[q][0].f) + w1 * bfhi(og[q][1].f) + w2 * bfhi(og[q][2].f)) * bfhi(z.f); o.f = cvtpk(lo, hi); }
            CMB(x) CMB(y) CMB(z) CMB(w)
#undef CMB
            *(u32x4*)(SAZ + (size_t)(b * 8192 + s) * 512 + h * 64 + ch * 8) = o;
        }
    }
}


constexpr size_t WS_BAR = 240 * 1024;
__device__ __forceinline__ void grid_barrier(unsigned* bar, unsigned& target) {
    asm volatile("s_waitcnt vmcnt(0) lgkmcnt(0)" ::: "memory");
    __syncthreads();
    if (threadIdx.x == 0) {
        target += gridDim.x;
        __builtin_amdgcn_fence(__ATOMIC_RELEASE, "agent");
        asm volatile("s_waitcnt vmcnt(0)" ::: "memory");
        __hip_atomic_fetch_add(bar, 1u, __ATOMIC_RELAXED, __HIP_MEMORY_SCOPE_AGENT);
        unsigned spins = 0;
        while (__hip_atomic_load(bar, __ATOMIC_RELAXED, __HIP_MEMORY_SCOPE_AGENT) < target) { __builtin_amdgcn_s_sleep(20); if (++spins > (1u << 21)) break; }
        __builtin_amdgcn_fence(__ATOMIC_ACQUIRE, "agent");
        asm volatile("s_waitcnt vmcnt(0)" ::: "memory");
    }
    __syncthreads();
}

__global__ void __launch_bounds__(512, 2) fwd_kernel(Args A) {
    extern __shared__ __attribute__((aligned(16))) unsigned char lds_raw[];
    LAS unsigned char* lds = (LAS unsigned char*)lds_raw;
    PG8_LAS unsigned char* glds = (PG8_LAS unsigned char*)lds_raw;
    const int lo = A.ph_lo, hi = A.ph_hi, G = gridDim.x, bx = blockIdx.x;
    unsigned char* ws = A.ws;
#define IN(k) (lo <= (k) && (k) < hi)
    unsigned bar_target = 0u; unsigned* bar_word = (unsigned*)(ws + WS_BAR);
#define SEAM(k) do { if (IN(k) && IN((k) + 1)) { grid_barrier(bar_word, bar_target); } } while (0)
    if (A.coop == 12345) cg::this_grid().sync();
    int ph = 0;

    if (IN(ph)) p0_prologue(A, lds);

    SEAM(ph); ++ph;
    if (IN(ph)) p_modulate(A);
    SEAM(ph); ++ph;
#pragma unroll 1
    for (int l = 0; l < DEPTH; ++l) {
        const pg8::bf16_t* W1T = (const pg8::bf16_t*)(ws + WS_W1T) + (size_t)l * NIN * 1024;
        const bool gates_in_p1 = (l == 0);
        const pg8::bf16_t* Gbuf = gates_in_p1 ? (const pg8::bf16_t*)A.out : (const pg8::bf16_t*)(ws + WS_G);
        if (IN(ph)) {
            const int n1 = gates_in_p1 ? NIN : N1;
            pg8::Gemm g{(const pg8::bf16_t*)(ws + WS_U), W1T, MT, n1, 1024}; pg8::StaticOrder S; S.init(MT, n1, G, bx);
            pg8::Epi1 E{ws, A.qng + l * 64, A.kng + l * 64, (const float*)(ws + WS_ROPE), (pg8::bf16_t*)A.out, A.b_gate + l * 2048};

            pg8::gemm_phase<pg8::Epi1, pg8::StaticOrder, true, true>(glds, g, S, E);
            if (l + 1 < DEPTH) {
                const int nwg = (MT / 256) * (n1 / 256), rem = nwg % G;
                if (rem == 0) convert_weights(A, lds, l + 1, bx, G); else if (bx >= rem) convert_weights(A, lds, l + 1, bx - rem, G - rem);
            }

        }
        SEAM(ph); ++ph;
        if (IN(ph)) {
            for (int u = bx; u < 256 + 1024; u += G) {
                if (u < 256) attnA_unit(lds, A, u);
                if (u >= 256) {
                    int ub = u - 256;
                    if (G == 256) {
                        const int k = ub >> 8, xcd = bx & 7, j = (bx >> 3) * 4 + k;
                        ub = (xcd >> 1) * 256 + ((xcd & 1) * 4 + (j >> 5)) * 32 + (j & 31); }
                    attnB_unit(lds, A, ub, A.kng + l * 64);
                }
 }
            __syncthreads();
        }
        SEAM(ph); ++ph;
        if (IN(ph) && !gates_in_p1) {
            pg8::Gemm g{(const pg8::bf16_t*)(ws + WS_U), W1T + (size_t)N1 * 1024, MT, 2048, 1024}; pg8::GateOrder S; S.init(MT, G, bx);
            pg8::EpiGate E{(pg8::bf16_t*)(ws + WS_G), A.b_gate + l * 2048};

            pg8::gemm_phase<pg8::EpiGate, pg8::GateOrder, true, true>(glds, g, S, E);

        }
        if (IN(ph)) {
            { constexpr int DPM = (int)((WS_SBZ - WS_SAZ) / (256 * 512 * 2)), DPN = (int)((WS_WPBT - WS_WPAT) / (256 * 512 * 2));
              static_assert((size_t)DPM * 256 * 512 * 2 == WS_SBZ - WS_SAZ && (size_t)DPN * 256 * 512 * 2 == WS_WPBT - WS_WPAT && DPM >= MT / 256, "pass b of the merge is reached by whole-tile offsets");
              pg8::Gemm g{(const pg8::bf16_t*)(ws + WS_SAZ), (const pg8::bf16_t*)(ws + WS_WPAT) + (size_t)l * 1024 * 512, MT, 1024, 512}; pg8::MergeOrder S; S.init(MT, G, bx, DPM, DPN);
              pg8::EpiMerge2 E{(pg8::bf16_t*)(ws + WS_MG), Gbuf, DPM, DPN};
              pg8::gemm_phase<pg8::EpiMerge2, pg8::MergeOrder, true, true>(glds, g, S, E); }
        }
        SEAM(ph); ++ph;
        if (IN(ph)) {
            pg8::Gemm g{(const pg8::bf16_t*)(ws + WS_MG), (const pg8::bf16_t*)(ws + WS_WOT) + (size_t)l * 1024 * 1024, MT, 1024, 1024}; pg8::StaticOrder S; S.init(MT, 1024, G, bx);
            pg8::EpiOut E{l == 0 ? A.x : A.out, A.out, (const float*)(ws + WS_MOD) + (size_t)l * 4 * 3072 + 2048, ALPHA};

            pg8::gemm_phase<pg8::EpiOut, pg8::StaticOrder, true, true>(glds, g, S, E);

        }
        SEAM(ph); ++ph;

        if (IN(ph)) p_layernorm(A, l);

        SEAM(ph); ++ph;
    }
#undef IN
#undef SEAM
}
constexpr int N_PHASES = 2 + 5 * DEPTH;

#ifndef MK_SPLIT
#define MK_SPLIT 0
#endif
extern "C" void kernel_launch(void* const* d_in, const int* in_sizes, int n_in, void* d_out, int out_size, void* d_ws, size_t ws_size, hipStream_t stream) {
    static int grid = 0;
    if (grid == 0) {
        if (n_in != 14 || in_sizes[0] != MT * DM || out_size != MT * DM || ws_size < WS_END) { fprintf(stderr, "kernel_launch: unexpected shapes (n_in %d, ws %zu < %zu)\n", n_in, ws_size, (size_t)WS_END); grid = -1; return; }
        int dev = 0, cus = 0, per_cu = 0;
        hipGetDevice(&dev); hipDeviceGetAttribute(&cus, hipDeviceAttributeMultiprocessorCount, dev);
        if (hipFuncSetAttribute((const void*)fwd_kernel, hipFuncAttributeMaxDynamicSharedMemorySize, LDS_BYTES) != hipSuccess) { fprintf(stderr, "kernel_launch: hipFuncSetAttribute failed\n"); grid = -1; return; }
        if (hipOccupancyMaxActiveBlocksPerMultiprocessor(&per_cu, (const void*)fwd_kernel, 512, LDS_BYTES) != hipSuccess || per_cu < 1) { fprintf(stderr, "kernel_launch: occupancy query says %d\n", per_cu); per_cu = 1; }
        (void)hipGetLastError();
        grid = cus * 1;
    }
    if (grid < 0) return;
    Args a{};
    a.x = (const float*)d_in[0]; a.c = (const float*)d_in[1]; a.rel = (const float*)d_in[2]; a.ln_g = (const float*)d_in[3]; a.ln_b = (const float*)d_in[4];
    a.w_ada = (const float*)d_in[5]; a.b_ada = (const float*)d_in[6]; a.w_in = (const float*)d_in[7]; a.b_gate = (const float*)d_in[8];
    a.qng = (const float*)d_in[9]; a.kng = (const float*)d_in[10]; a.w_pa = (const float*)d_in[11]; a.w_pb = (const float*)d_in[12]; a.w_o = (const float*)d_in[13];
    a.out = (float*)d_out; a.ws = (unsigned char*)d_ws; a.pad = 0;
#if MK_SPLIT
    for (int p = 0; p < N_PHASES; ++p) { a.ph_lo = p; a.ph_hi = p + 1; a.coop = 0;
        hipLaunchKernelGGL(fwd_kernel, dim3(grid), dim3(512), LDS_BYTES, stream, a); }
#else
    if (hipMemsetAsync((char*)d_ws + WS_BAR, 0, 256, stream) != hipSuccess) { fprintf(stderr, "kernel_launch: memset failed\n"); return; }
    a.ph_lo = 0; a.ph_hi = N_PHASES; a.coop = 1;
    void* kargs[] = {&a};
    hipError_t e = hipLaunchCooperativeKernel((const void*)fwd_kernel, dim3(grid), dim3(512), kargs, LDS_BYTES, stream);
    if (e != hipSuccess) fprintf(stderr, "kernel_launch: cooperative launch failed: %s (grid %d)\n", hipGetErrorString(e), grid);
#endif
}
```

```cpp
#include <hip/hip_runtime.h>
#include <hip/hip_cooperative_groups.h>
#include <cstdio>
#include <cstdint>
namespace cg = cooperative_groups;
constexpr int NB = 4, SEQ = 8192, DM = 1024, MT = NB * SEQ, DEPTH = 2;
constexpr int N1 = 6400, NIN = 8448;
constexpr float ALPHA = 1.41421356237309515f;
constexpr float LOG2E = 1.44269504088896341f;
constexpr float QK_C = 0.125f * LOG2E;
constexpr int LDS_BYTES = 131072;

constexpr size_t WS_MOD = 0;
constexpr size_t WS_ROPE = 128 * 1024;
constexpr size_t WS_BIAS = 160 * 1024;
constexpr size_t WS_LSE = 256 * 1024;
constexpr size_t WS_W1T = WS_LSE + (size_t)3 * 4 * 8 * 8192 * 4;
constexpr size_t WS_WPAT = WS_W1T + (size_t)2 * NIN * 1024 * 2;
constexpr size_t WS_WPBT = WS_WPAT + (size_t)2 * 1024 * 512 * 2;
constexpr size_t WS_WOT = WS_WPBT + (size_t)2 * 1024 * 512 * 2;
constexpr size_t WS_U = WS_WOT + (size_t)2 * 1024 * 1024 * 2;
constexpr size_t WS_QA = WS_U + (size_t)MT * 1024 * 2;
constexpr size_t SZ_A = (size_t)NB * 3 * 8 * SEQ * 64 * 2;
constexpr size_t WS_KA = WS_QA + SZ_A, WS_VA = WS_KA + SZ_A;
constexpr size_t WS_SAZ = WS_VA + SZ_A;
constexpr size_t WS_QB = WS_SAZ + (size_t)MT * 512 * 2;
constexpr size_t WS_KB = WS_QB + (size_t)MT * 512 * 2;
constexpr size_t WS_VB = WS_KB + (size_t)MT * 128 * 2;
constexpr size_t WS_SBZ = WS_VB + (size_t)MT * 128 * 2;
constexpr size_t WS_END = WS_SBZ + (size_t)MT * 512 * 2;
constexpr size_t WS_G = WS_QA;
constexpr size_t WS_MG = WS_VA;
static_assert((size_t)MT * 2048 * 2 <= 2 * SZ_A && (size_t)MT * 1024 * 2 <= SZ_A, "overlays");
static_assert(WS_END <= (size_t)536870912, "d_ws map must fit 4x the largest tensor");

namespace pg8 {
#define PG8_LAS __attribute__((address_space(3)))
typedef unsigned short bf16_t;
typedef short bf16x8 __attribute__((ext_vector_type(8)));
typedef float f32x4 __attribute__((ext_vector_type(4)));
typedef unsigned u32x4 __attribute__((ext_vector_type(4)));
constexpr int BM = 256, BK = 64, HALF = 128, HTB = HALF * BK * 2  , STAGE_BYTES = 8 * HTB, NXCD = 8, WGM = 8;

__host__ __device__ __forceinline__ int lds_byte(int r, int c) { const int st = (r >> 4) * 2 + (c >> 5), rr = r & 15, cc = c & 31, ob = rr * 64 + cc * 2; return st * 1024 + (ob ^ (((ob >> 9) & 1) << 5)); }
__host__ __device__ __forceinline__ void stage_rc(int b, int& R, int& C) { const int st = b / 1024, sb = b % 1024, swz = sb ^ (((sb >> 9) & 1) << 5); R = (st >> 1) * 16 + swz / 64; C = (st & 1) * 32 + (swz % 64) / 2; }
__host__ __device__ __forceinline__ int perm32(int rho) { const int n = rho >> 4, i = rho & 15; return 8 * (i >> 2) + 4 * n + (i & 3); }

struct Unit { int pm, pn; };
struct Gemm { const bf16_t* A; const bf16_t* Bt; int M, N, K; };

struct StaticOrder {
    int nM, nN, nwg, G, c;
    __host__ __device__ void init(int M, int N, int G_, int c_) { nM = M / BM; nN = N / BM; nwg = nM * nN; G = G_; c = c_; }
    __host__ __device__ bool next(int i, Unit& u) const {
        const long L = (long)i * G + c; if (L >= nwg) return false;
        int wgid = (int)L; { const int q = nwg / NXCD, r = nwg % NXCD, xcd = wgid % NXCD, off = wgid / NXCD; wgid = (xcd < r ? xcd * (q + 1) : r * (q + 1) + (xcd - r) * q) + off; }
        const int nig = WGM * nN, gid = wgid / nig, fm = gid * WGM, gsz = (nM - fm) < WGM ? (nM - fm) : WGM;
        u.pm = fm + ((wgid % nig) % gsz); u.pn = (wgid % nig) / gsz; return true;
    }
    __device__ __forceinline__ void a_ready(const Unit&) const {}
    __device__ __forceinline__ void done(const Unit&) const {}
};

typedef __bf16 bf16x2_c __attribute__((ext_vector_type(2)));
typedef float f32x2_c __attribute__((ext_vector_type(2)));
__device__ __forceinline__ unsigned cvt_pk_bf16(float lo, float hi) { f32x2_c v = {lo, hi}; bf16x2_c b = __builtin_convertvector(v, bf16x2_c); return __builtin_bit_cast(unsigned, b); }
typedef unsigned long long u64_t;
typedef float f32x2e __attribute__((ext_vector_type(2)));
__device__ __forceinline__ u32x4 pack8(const f32x4& a, const f32x4& b) { u32x4 w; w.x = cvt_pk_bf16(a[0], a[1]); w.y = cvt_pk_bf16(a[2], a[3]); w.z = cvt_pk_bf16(b[0], b[1]); w.w = cvt_pk_bf16(b[2], b[3]); return w; }
__device__ __forceinline__ float bf_lo(unsigned u) { return __uint_as_float(u << 16); }
__device__ __forceinline__ float bf_hi(unsigned u) { return __uint_as_float(u & 0xffff0000u); }
__device__ __forceinline__ float fast_sigmoid(float x) { return __builtin_amdgcn_rcpf(1.0f + __builtin_amdgcn_exp2f(-1.44269504089f * x)); }

struct Epi1 {
    static constexpr bool PERM = false, AFTER_DRAIN = false;
    unsigned char* ws;
    const float *qg, *kg; const float* rope;
    bf16_t* Gd; const float* bgate;
    __device__ __forceinline__ void operator()(const f32x4 (&acc)[2][2][4][2], const Unit& u, int wr, int wc, int fr, int fq) const {
        const int T = u.pn;
        const int row0 = u.pm * BM + wr * 64 + fr;
        if (T < 18) {
            const int rg = T / 6, t6 = T - 6 * rg, g = t6 >> 1, lg = 2 * g;
            bf16_t* base = (bf16_t*)(ws + WS_QA + (size_t)rg * SZ_A);
#pragma unroll
            for (int ai = 0; ai < 2; ++ai)
#pragma unroll
                for (int m = 0; m < 4; ++m) {
                    const int row = row0 + ai * HALF + m * 16, b = row >> 13, s = row & 8191;
                    const int p = ((s & ((1 << lg) - 1)) << (13 - lg)) | (s >> lg);
#pragma unroll
                    for (int bj = 0; bj < 2; ++bj) {
                        const int head = (t6 & 1) * 4 + 2 * bj + (wc >> 1), hc0 = 32 * (wc & 1) + 8 * fq;
                        bf16_t* dst = base + ((size_t)(((b * 3 + g) * 8 + head) * 8192 + p) * 64 + hc0);
                        *(u32x4*)dst = pack8(acc[ai][bj][m][0], acc[ai][bj][m][1]);
                    }
                }
        } else if (T >= 25) {
            const int col0 = (T - 25) * BM + 32 * wc + 8 * fq;
            f32x4 bv[2][2];
#pragma unroll
            for (int bj = 0; bj < 2; ++bj)
#pragma unroll
                for (int n = 0; n < 2; ++n) bv[bj][n] = *(const f32x4*)(bgate + col0 + 128 * bj + 4 * n);
#pragma unroll
            for (int ai = 0; ai < 2; ++ai)
#pragma unroll
                for (int m = 0; m < 4; ++m) {
                    const int row = row0 + ai * HALF + m * 16;
#pragma unroll
                    for (int bj = 0; bj < 2; ++bj) {
                        f32x4 a = acc[ai][bj][m][0] + bv[bj][0], c = acc[ai][bj][m][1] + bv[bj][1];
#pragma unroll
                        for (int j = 0; j < 4; ++j) { a[j] = fast_sigmoid(a[j]); c[j] = fast_sigmoid(c[j]); }
                        *(u32x4*)(Gd + (size_t)row * 2048 + col0 + 128 * bj) = pack8(a, c);
                    }
                }
        } else if (T < 20 || T >= 23) {
            bf16_t* out = (bf16_t*)(ws + (T < 20 ? WS_SAZ : WS_SBZ)); const int ct = T < 20 ? T - 18 : T - 23;
#pragma unroll
            for (int ai = 0; ai < 2; ++ai)
#pragma unroll
                for (int m = 0; m < 4; ++m) {
                    const int row = row0 + ai * HALF + m * 16;
#pragma unroll
                    for (int bj = 0; bj < 2; ++bj) {
                        f32x4 a = acc[ai][bj][m][0], c = acc[ai][bj][m][1];
#pragma unroll
                        for (int j = 0; j < 4; ++j) { a[j] = a[j] * fast_sigmoid(a[j]); c[j] = c[j] * fast_sigmoid(c[j]); }
                        *(u32x4*)(out + (size_t)row * 512 + ct * 256 + 128 * bj + 32 * wc + 8 * fq) = pack8(a, c);
                    }
                }
        } else if (T == 22 && wc >= 2) {
            const int head = wc - 2;
#pragma unroll
            for (int ai = 0; ai < 2; ++ai)
#pragma unroll
                for (int m = 0; m < 4; ++m) {
                    const int row = row0 + ai * HALF + m * 16, b = row >> 13, s = row & 8191;
#pragma unroll
                    for (int bj = 0; bj < 2; ++bj)
                        *(u32x4*)((bf16_t*)(ws + WS_VB) + ((size_t)((b * 2 + head) * 8192 + s) * 64 + 32 * bj + 8 * fq)) = pack8(acc[ai][bj][m][0], acc[ai][bj][m][1]);
                }
        } else {
            const bool isk = (T == 22);
            const int head = isk ? wc : (T - 20) * 4 + wc, nH = isk ? 2 : 8;
            bf16_t* dst = (bf16_t*)(ws + (isk ? WS_KB : WS_QB)); const float* gv = isk ? kg : qg;
            f32x4 gq[2][2];
#pragma unroll
            for (int bj = 0; bj < 2; ++bj)
#pragma unroll
                for (int n = 0; n < 2; ++n) gq[bj][n] = *(const f32x4*)(gv + 16 * (2 * bj + n) + 4 * fq);
#pragma unroll
            for (int ai = 0; ai < 2; ++ai)
#pragma unroll
                for (int m = 0; m < 4; ++m) {
                    const int row = row0 + ai * HALF + m * 16, b = row >> 13, s = row & 8191;
                    float ss = 0.f;
#pragma unroll
                    for (int bj = 0; bj < 2; ++bj)
#pragma unroll
                        for (int n = 0; n < 2; ++n) { const f32x4 v = acc[ai][bj][m][n]; ss += (v[0] * v[0] + v[1] * v[1]) + (v[2] * v[2] + v[3] * v[3]); }
                    ss += __shfl_xor(ss, 16); ss += __shfl_xor(ss, 32);
                    const float r = 1.0f / sqrtf(ss * (1.0f / 64.0f) + 1e-6f);
                    bf16_t* drow = dst + ((size_t)((b * nH + head) * 8192 + s) * 64 + 4 * fq);
#pragma unroll
                    for (int bj = 0; bj < 2; ++bj) {
                        const int pos = bj == 0 ? (s >> 6) : (s & 63);
                        const f32x4 cs0 = *(const f32x4*)(rope + (pos * 16 + 4 * fq) * 2), cs1 = *(const f32x4*)(rope + (pos * 16 + 4 * fq) * 2 + 4);
                        const f32x4 cc = {cs0[0], cs0[2], cs1[0], cs1[2]}, sn = {cs0[1], cs0[3], cs1[1], cs1[3]};
                        f32x4 x1 = acc[ai][bj][m][0] * r * gq[bj][0], x2 = acc[ai][bj][m][1] * r * gq[bj][1], o1, o2;
#pragma unroll
                        for (int j = 0; j < 4; ++j) { o1[j] = x1[j] * cc[j] - x2[j] * sn[j]; o2[j] = x2[j] * cc[j] + x1[j] * sn[j]; }
                        u64_t w1 = (u64_t)cvt_pk_bf16(o1[0], o1[1]) | ((u64_t)cvt_pk_bf16(o1[2], o1[3]) << 32);
                        u64_t w2 = (u64_t)cvt_pk_bf16(o2[0], o2[1]) | ((u64_t)cvt_pk_bf16(o2[2], o2[3]) << 32);
                        *(u64_t*)(drow + 16 * (2 * bj)) = w1; *(u64_t*)(drow + 16 * (2 * bj + 1)) = w2;
                    }
                }
        }
    }
};

struct EpiGate {
    static constexpr bool PERM = false, AFTER_DRAIN = false;
    bf16_t* G; const float* bias;
    __device__ __forceinline__ void operator()(const f32x4 (&acc)[2][2][4][2], const Unit& u, int wr, int wc, int fr, int fq) const {
        const int row0 = u.pm * BM + wr * 64 + fr, col0 = u.pn * BM + 32 * wc + 8 * fq;
        f32x4 bv[2][2];
#pragma unroll
        for (int bj = 0; bj < 2; ++bj)
#pragma unroll
            for (int n = 0; n < 2; ++n) bv[bj][n] = *(const f32x4*)(bias + col0 + 128 * bj + 4 * n);
#pragma unroll
        for (int ai = 0; ai < 2; ++ai)
#pragma unroll
            for (int m = 0; m < 4; ++m) {
                const int row = row0 + ai * HALF + m * 16;
#pragma unroll
                for (int bj = 0; bj < 2; ++bj) {
                    f32x4 a = acc[ai][bj][m][0] + bv[bj][0], c = acc[ai][bj][m][1] + bv[bj][1];
#pragma unroll
                    for (int j = 0; j < 4; ++j) { a[j] = fast_sigmoid(a[j]); c[j] = fast_sigmoid(c[j]); }
                    *(u32x4*)(G + (size_t)row * 2048 + col0 + 128 * bj) = pack8(a, c);
                }
            }
    }
};

template <bool ADD> struct EpiMerge {
    static constexpr bool PERM = false, AFTER_DRAIN = false;
    bf16_t* MG; const bf16_t* G; int goff;
    __device__ __forceinline__ void operator()(const f32x4 (&acc)[2][2][4][2], const Unit& u, int wr, int wc, int fr, int fq) const {
        const int row0 = u.pm * BM + wr * 64 + fr, col0 = u.pn * BM + 32 * wc + 8 * fq;
#pragma unroll
        for (int ai = 0; ai < 2; ++ai) {
            u32x4 gw[4][2], ow[4][2];
#pragma unroll
            for (int m = 0; m < 4; ++m)
#pragma unroll
                for (int bj = 0; bj < 2; ++bj) { const int row = row0 + ai * HALF + m * 16;
                    gw[m][bj] = *(const u32x4*)(G + (size_t)row * 2048 + goff + col0 + 128 * bj);
                    if (ADD) ow[m][bj] = *(const u32x4*)(MG + (size_t)row * 1024 + col0 + 128 * bj); }
#pragma unroll
            for (int m = 0; m < 4; ++m)
#pragma unroll
                for (int bj = 0; bj < 2; ++bj) { const int row = row0 + ai * HALF + m * 16;
                    const u32x4 g4 = gw[m][bj];
                    f32x4 a = acc[ai][bj][m][0], c = acc[ai][bj][m][1];
                    a[0] *= bf_lo(g4.x); a[1] *= bf_hi(g4.x); a[2] *= bf_lo(g4.y); a[3] *= bf_hi(g4.y);
                    c[0] *= bf_lo(g4.z); c[1] *= bf_hi(g4.z); c[2] *= bf_lo(g4.w); c[3] *= bf_hi(g4.w);
                    if (ADD) { const u32x4 o4 = ow[m][bj];
                        a[0] += bf_lo(o4.x); a[1] += bf_hi(o4.x); a[2] += bf_lo(o4.y); a[3] += bf_hi(o4.y);
                        c[0] += bf_lo(o4.z); c[1] += bf_hi(o4.z); c[2] += bf_lo(o4.w); c[3] += bf_hi(o4.w); }
                    *(u32x4*)(MG + (size_t)row * 1024 + col0 + 128 * bj) = pack8(a, c);
                }
        }
    }
};

struct EpiOut {
    static constexpr bool PERM = false, AFTER_DRAIN = false;
    const float* xin; float* pre; const float* gate; float alpha;
    __device__ __forceinline__ void operator()(const f32x4 (&acc)[2][2][4][2], const Unit& u, int wr, int wc, int fr, int fq) const {
        const int row0 = u.pm * BM + wr * 64 + fr, col0 = u.pn * BM + 32 * wc + 8 * fq;
        const int b = (u.pm * BM) >> 13;
        f32x4 gv[2][2];
#pragma unroll
        for (int bj = 0; bj < 2; ++bj)
#pragma unroll
            for (int n = 0; n < 2; ++n) gv[bj][n] = *(const f32x4*)(gate + b * 3072 + col0 + 128 * bj + 4 * n);
#pragma unroll
        for (int ai = 0; ai < 2; ++ai) {
            f32x4 xv[4][2][2];
#pragma unroll
            for (int m = 0; m < 4; ++m) { const size_t off = (size_t)(row0 + ai * HALF + m * 16) * 1024 + col0;
#pragma unroll
                for (int bj = 0; bj < 2; ++bj)
#pragma unroll
                    for (int n = 0; n < 2; ++n) xv[m][bj][n] = *(const f32x4*)(xin + off + 128 * bj + 4 * n); }
#pragma unroll
            for (int m = 0; m < 4; ++m) { const size_t off = (size_t)(row0 + ai * HALF + m * 16) * 1024 + col0;
#pragma unroll
                for (int bj = 0; bj < 2; ++bj)
#pragma unroll
                    for (int n = 0; n < 2; ++n) *(f32x4*)(pre + off + 128 * bj + 4 * n) = xv[m][bj][n] * alpha + gv[bj][n] * acc[ai][bj][m][n]; }
        }
    }
};

struct GateOrder {
    StaticOrder S;
    __host__ __device__ void init(int M, int G_, int c_) { S.init(M, 1024, G_, c_); }
    __host__ __device__ bool next(int i, Unit& u) const { Unit m; if (!S.next(i >> 1, m)) return false; u.pm = m.pm; u.pn = m.pn + 4 * (i & 1); return true; }
    __device__ __forceinline__ void a_ready(const Unit&) const {}
    __device__ __forceinline__ void done(const Unit&) const {}
};

struct MergeOrder {
    StaticOrder S; int dpm, dpn;
    __host__ __device__ void init(int M, int G_, int c_, int dpm_, int dpn_) { S.init(M, 1024, G_, c_); dpm = dpm_; dpn = dpn_; }
    __host__ __device__ bool next(int i, Unit& u) const { Unit m; if (!S.next(i >> 1, m)) return false; u.pm = m.pm + (i & 1) * dpm; u.pn = m.pn + (i & 1) * dpn; return true; }
    __device__ __forceinline__ void a_ready(const Unit&) const {}
    __device__ __forceinline__ void done(const Unit&) const {}
};
struct EpiMerge2 {
    static constexpr bool PERM = false, AFTER_DRAIN = false;
    bf16_t* MG; const bf16_t* G; int dpm, dpn;
    __device__ __forceinline__ void operator()(const f32x4 (&acc)[2][2][4][2], const Unit& u, int wr, int wc, int fr, int fq) const {
        const bool pb = u.pm >= dpm; Unit r; r.pm = pb ? u.pm - dpm : u.pm; r.pn = pb ? u.pn - dpn : u.pn;
        if (pb) { EpiMerge<true> E{MG, G, 1024}; E(acc, r, wr, wc, fr, fq); } else { EpiMerge<false> E{MG, G, 0}; E(acc, r, wr, wc, fr, fq); }
    }
};
template <class Epi, class Sched, bool ALIGN_EPI = false, bool SP2 = false>
__device__ __forceinline__ void gemm_phase(PG8_LAS unsigned char* lds, const Gemm g, const Sched& S, const Epi& E) {
    int tid_l = threadIdx.x; asm volatile("" : "+v"(tid_l));
    const int tid = tid_l, wid = __builtin_amdgcn_readfirstlane(tid >> 6), lane = tid & 63, wr = wid >> 2, wc = wid & 3, fr = lane & 15, fq = lane >> 4;
    const int K = g.K, nt = K / BK;
    unsigned voffA[2], voffB[2];
#pragma unroll
    for (int i = 0; i < 2; ++i) { int R, C; stage_rc(tid * 16 + i * 8192, R, C); const int Rb = Epi::PERM ? ((R & ~31) + perm32(R & 31)) : R;
        voffA[i] = (unsigned)(R * K + C) * 2u; voffB[i] = (unsigned)(Rb * K + C) * 2u; }
    const size_t kstep = (size_t)(BK * 2);
    const size_t hstep = (size_t)HALF * K * 2;
    const size_t tstep = 2 * hstep;
    const unsigned ldsw = (unsigned)wid * 1024u;
    const int aoff = lds_byte(wr * 64 + fr, fq * 8), boff = lds_byte(wc * 32 + fr, fq * 8);
#define PG8_SA(b, h) (((b) * 2 + (h)) * HTB)
#define PG8_SB(b, h) ((4 + (b) * 2 + (h)) * HTB)
#define PG8_STAGE(bufoff, gbase, voff) do { _Pragma("unroll") for (int _i = 0; _i < 2; ++_i) \
        __builtin_amdgcn_global_load_lds((const unsigned*)((const char*)(gbase) + (voff)[_i]), (PG8_LAS unsigned*)(lds + (bufoff) + ldsw + _i * 8192), 16, 0, 0); } while (0)
#define PG8_LDA(dst, b, h) do { _Pragma("unroll") for (int m = 0; m < 4; ++m) _Pragma("unroll") for (int k = 0; k < 2; ++k) dst[m][k] = *(const PG8_LAS bf16x8*)(lds + PG8_SA(b, h) + aoff + m * 2048 + k * 1024); } while (0)
#define PG8_LDB(dst, b, h) do { _Pragma("unroll") for (int n = 0; n < 2; ++n) _Pragma("unroll") for (int k = 0; k < 2; ++k) dst[n][k] = *(const PG8_LAS bf16x8*)(lds + PG8_SB(b, h) + boff + n * 2048 + k * 1024); } while (0)
#define PG8_MMA(ai, bj, At, Bt) do { __builtin_amdgcn_s_setprio(1); _Pragma("unroll") for (int m = 0; m < 4; ++m) _Pragma("unroll") for (int n = 0; n < 2; ++n) _Pragma("unroll") for (int k = 0; k < 2; ++k) \
        acc[ai][bj][m][n] = __builtin_amdgcn_mfma_f32_16x16x32_bf16(Bt[n][k], At[m][k], acc[ai][bj][m][n], 0, 0, 0); __builtin_amdgcn_s_setprio(0); } while (0)
#define PG8_WAIT_V(n) asm volatile("s_waitcnt vmcnt(" #n ")" ::: "memory")
#define PG8_WAIT_L(n) asm volatile("s_waitcnt lgkmcnt(" #n ")" ::: "memory")
#define PG8_BAR __builtin_amdgcn_s_barrier()
#define PG8_SCHED __builtin_amdgcn_sched_barrier(0)
    Unit cur, nxt; int ui = 0;
    if (!S.next(0, cur)) return;
    f32x4 acc[2][2][4][2];
#pragma unroll
    for (int a = 0; a < 2; ++a)
#pragma unroll
        for (int b = 0; b < 2; ++b)
#pragma unroll
            for (int m = 0; m < 4; ++m)
#pragma unroll
                for (int n = 0; n < 2; ++n) acc[a][b][m][n] = (f32x4){0.f, 0.f, 0.f, 0.f};
    bf16x8 At[4][2], B0[2][2], B1[2][2];
    const char* cA = (const char*)g.A + (size_t)cur.pm * tstep; const char* cB = (const char*)g.Bt + (size_t)cur.pn * tstep;
    S.a_ready(cur);
    if constexpr (SP2) {
        PG8_STAGE(PG8_SB(0, 0), cB, voffB); PG8_STAGE(PG8_SB(0, 1), cB + hstep, voffB); PG8_STAGE(PG8_SA(0, 0), cA, voffA); PG8_STAGE(PG8_SA(0, 1), cA + hstep, voffA);
        if (wr == 1) PG8_BAR;
        PG8_WAIT_V(2); PG8_BAR;
        PG8_STAGE(PG8_SB(1, 0), cB + kstep, voffB); PG8_STAGE(PG8_SA(1, 0), cA + kstep, voffA); PG8_STAGE(PG8_SB(1, 1), cB + hstep + kstep, voffB);
        PG8_WAIT_V(6); PG8_BAR;
    } else {
        PG8_STAGE(PG8_SB(0, 0), cB, voffB); PG8_STAGE(PG8_SA(0, 0), cA, voffA); PG8_STAGE(PG8_SB(0, 1), cB + hstep, voffB); PG8_STAGE(PG8_SA(0, 1), cA + hstep, voffA);
        if (wr == 1) PG8_BAR;
        PG8_WAIT_V(4); PG8_BAR;
        PG8_STAGE(PG8_SB(1, 0), cB + kstep, voffB); PG8_STAGE(PG8_SA(1, 0), cA + kstep, voffA); PG8_STAGE(PG8_SB(1, 1), cB + hstep + kstep, voffB);
        PG8_WAIT_V(6); PG8_BAR;
    }
    for (;;) {
        const bool has_next = S.next(ui + 1, nxt);
        const char* nA = has_next ? (const char*)g.A + (size_t)nxt.pm * tstep : cA; const char* nB = has_next ? (const char*)g.Bt + (size_t)nxt.pn * tstep : cB;
        for (int t = 0; t < nt; t += 2) {
            const bool last = (t == nt - 2);
            const char* a1 = cA + (size_t)(t + 1) * kstep;
            const char* a2 = last ? nA : cA + (size_t)(t + 2) * kstep; const char* b2 = last ? nB : cB + (size_t)(t + 2) * kstep;
            const char* a3 = a2 + kstep; const char* b3 = b2 + kstep;
            if (last && has_next) S.a_ready(nxt);
            if constexpr (SP2) {
            PG8_LDB(B0, 0, 0); PG8_LDB(B1, 0, 1); PG8_SCHED; PG8_LDA(At, 0, 0); PG8_STAGE(PG8_SA(1, 1), a1 + hstep, voffA);
            PG8_WAIT_V(8); PG8_WAIT_L(0); PG8_BAR; PG8_MMA(0, 0, At, B0); PG8_MMA(0, 1, At, B1); PG8_BAR; PG8_SCHED;
            PG8_LDA(At, 0, 1); PG8_STAGE(PG8_SB(0, 0), b2, voffB); PG8_STAGE(PG8_SB(0, 1), b2 + hstep, voffB); PG8_STAGE(PG8_SA(0, 0), a2, voffA);
            PG8_WAIT_V(8); PG8_WAIT_L(0); PG8_BAR; PG8_MMA(1, 0, At, B0); PG8_MMA(1, 1, At, B1); PG8_BAR; PG8_SCHED;
            PG8_LDB(B0, 1, 0); PG8_LDB(B1, 1, 1); PG8_SCHED; PG8_LDA(At, 1, 0); PG8_STAGE(PG8_SA(0, 1), a2 + hstep, voffA);
            PG8_WAIT_V(8); PG8_WAIT_L(0); PG8_BAR; PG8_MMA(0, 0, At, B0); PG8_MMA(0, 1, At, B1); PG8_BAR; PG8_SCHED;
            PG8_LDA(At, 1, 1); PG8_STAGE(PG8_SB(1, 0), b3, voffB); PG8_STAGE(PG8_SB(1, 1), b3 + hstep, voffB); PG8_STAGE(PG8_SA(1, 0), a3, voffA);
            PG8_WAIT_V(8); PG8_WAIT_L(0); PG8_BAR; PG8_MMA(1, 0, At, B0); PG8_MMA(1, 1, At, B1); PG8_BAR; PG8_SCHED;
            } else {
            PG8_LDB(B0, 0, 0); PG8_SCHED; PG8_LDA(At, 0, 0); PG8_STAGE(PG8_SA(1, 1), a1 + hstep, voffA);
            PG8_WAIT_L(8); PG8_BAR; PG8_WAIT_L(0); PG8_MMA(0, 0, At, B0); PG8_BAR; PG8_SCHED;
            PG8_LDB(B1, 0, 1); PG8_STAGE(PG8_SB(0, 0), b2, voffB);
            PG8_BAR; PG8_WAIT_L(0); PG8_MMA(0, 1, At, B1); PG8_BAR;
            PG8_LDA(At, 0, 1); PG8_STAGE(PG8_SA(0, 0), a2, voffA);
            PG8_BAR; PG8_WAIT_L(0); PG8_MMA(1, 0, At, B0); PG8_BAR; PG8_SCHED;
            PG8_STAGE(PG8_SB(0, 1), b2 + hstep, voffB);
            PG8_WAIT_V(6); PG8_BAR; PG8_MMA(1, 1, At, B1); PG8_BAR;
            PG8_LDB(B0, 1, 0); PG8_SCHED; PG8_LDA(At, 1, 0); PG8_STAGE(PG8_SA(0, 1), a2 + hstep, voffA);
            PG8_WAIT_L(8); PG8_BAR; PG8_WAIT_L(0); PG8_MMA(0, 0, At, B0); PG8_BAR; PG8_SCHED;
            PG8_LDB(B1, 1, 1); PG8_STAGE(PG8_SB(1, 0), b3, voffB);
            PG8_BAR; PG8_WAIT_L(0); PG8_MMA(0, 1, At, B1); PG8_BAR;
            PG8_LDA(At, 1, 1); PG8_STAGE(PG8_SA(1, 0), a3, voffA);
            PG8_BAR; PG8_WAIT_L(0); PG8_MMA(1, 0, At, B0); PG8_BAR; PG8_SCHED;
            PG8_STAGE(PG8_SB(1, 1), b3 + hstep, voffB);
            PG8_WAIT_V(6); PG8_BAR; PG8_MMA(1, 1, At, B1); PG8_BAR;
            }
        }
        if constexpr (ALIGN_EPI) { if (wr == 0) PG8_BAR; }
        if constexpr (!Epi::AFTER_DRAIN) { E(acc, cur, wr, wc, fr, fq); S.done(cur); }
        if (!has_next) break;
#pragma unroll
        for (int a = 0; a < 2; ++a)
#pragma unroll
            for (int b = 0; b < 2; ++b)
#pragma unroll
                for (int m = 0; m < 4; ++m)
#pragma unroll
                    for (int n = 0; n < 2; ++n) acc[a][b][m][n] = (f32x4){0.f, 0.f, 0.f, 0.f};
        cur = nxt; cA = nA; cB = nB; ++ui;
        if constexpr (ALIGN_EPI) { if (wr == 1) PG8_BAR; }
    }
    PG8_WAIT_V(0);
    if constexpr (!ALIGN_EPI) { if (wr == 0) PG8_BAR; }
    PG8_BAR;
    if constexpr (Epi::AFTER_DRAIN) { E.fused(acc, cur, wr, wc, fr, fq, lds, wid, lane); S.done(cur); }
#undef PG8_SA
#undef PG8_SB
#undef PG8_STAGE
#undef PG8_LDA
#undef PG8_LDB
#undef PG8_MMA
#undef PG8_WAIT_V
#undef PG8_WAIT_L
#undef PG8_BAR
#undef PG8_SCHED
}
}

#define LAS __attribute__((address_space(3)))
typedef unsigned short bf16;
typedef float f32x4 __attribute__((ext_vector_type(4)));
typedef float f32x16 __attribute__((ext_vector_type(16)));
typedef short bf16x8 __attribute__((ext_vector_type(8)));
typedef short s16x4 __attribute__((ext_vector_type(4)));
typedef unsigned u32x4 __attribute__((ext_vector_type(4)));
typedef unsigned u32x2 __attribute__((ext_vector_type(2)));
typedef unsigned long long u64;
#define MFMA32(a, b, c) __builtin_amdgcn_mfma_f32_32x32x16_bf16((a), (b), (c), 0, 0, 0)

struct Args {
    const float *x, *c, *rel, *ln_g, *ln_b, *w_ada, *b_ada, *w_in, *b_gate, *qng, *kng, *w_pa, *w_pb, *w_o;
    float* out; unsigned char* ws; int ph_lo, ph_hi, coop, pad;
};

typedef __bf16 bf16x2_t __attribute__((ext_vector_type(2)));
typedef float f32x2_t __attribute__((ext_vector_type(2)));
__device__ __forceinline__ unsigned cvtpk(float lo, float hi) { f32x2_t v = {lo, hi}; bf16x2_t b = __builtin_convertvector(v, bf16x2_t); return __builtin_bit_cast(unsigned, b); }
__device__ __forceinline__ int tid_fresh() { int t = threadIdx.x; asm volatile("" : "+v"(t)); return t; }
__device__ __forceinline__ float bflo(unsigned u) { return __uint_as_float(u << 16); }
__device__ __forceinline__ float bfhi(unsigned u) { return __uint_as_float(u & 0xffff0000u); }
__device__ __forceinline__ float wave_sum(float v) {
#pragma unroll
    for (int o = 1; o < 64; o <<= 1) v += __shfl_xor(v, o);
    return v;
}
__device__ __forceinline__ bf16x8 pack_frag(const f32x16& x, int s) {
    u32x4 p; p.x = cvtpk(x[8 * s], x[8 * s + 1]); p.y = cvtpk(x[8 * s + 2], x[8 * s + 3]); p.z = cvtpk(x[8 * s + 4], x[8 * s + 5]); p.w = cvtpk(x[8 * s + 6], x[8 * s + 7]);
    return __builtin_bit_cast(bf16x8, p);
}
__device__ __forceinline__ int crow(int i, int h) { return (i & 3) + 8 * (i >> 2) + 4 * h; }

__device__ __forceinline__ int slot_src(int kind, int tc) {
    const int bj = tc >> 7, wc = (tc >> 5) & 3, n = (tc >> 4) & 1, fq = (tc >> 2) & 3, j = tc & 3;
    const int plain = 128 * bj + 32 * wc + 8 * fq + 4 * n + j;
    const int ropec = 64 * wc + 16 * (2 * bj + n) + 4 * fq + j;
    const int vcol = 64 * wc + 32 * bj + 8 * fq + 4 * n + j;
    if (kind == 0) return plain;
    if (kind == 1) return ropec;
    return wc < 2 ? ropec : vcol;
}
__device__ __forceinline__ void transpose_item(LAS float* scr, const float* W, int K, int Nsrc, int c0, int k0, bf16* Bt, int n0, int kind) {
    const int tid = tid_fresh();
#pragma unroll 4
    for (int i = 0; i < 8; ++i) {
        const int e = i * 512 + tid, kk = e >> 6, c4 = (e & 63) * 4;
        const f32x4 v = *(const f32x4*)(W + (size_t)(k0 + kk) * Nsrc + c0 + c4);
        LAS float* d = scr + kk * 257 + c4; d[0] = v[0]; d[1] = v[1]; d[2] = v[2]; d[3] = v[3];
    }
    __syncthreads();
    const int tc = tid >> 1, kh = (tid & 1) * 32, sc = slot_src(kind, tc);
    bf16* drow = Bt + (size_t)(n0 + tc) * K + k0 + kh;
#pragma unroll
    for (int q = 0; q < 4; ++q) {
        const LAS float* s = scr + (kh + 8 * q) * 257 + sc;
        u32x4 o; o.x = cvtpk(s[0], s[257]); o.y = cvtpk(s[2 * 257], s[3 * 257]); o.z = cvtpk(s[4 * 257], s[5 * 257]); o.w = cvtpk(s[6 * 257], s[7 * 257]);
        *(u32x4*)(drow + 8 * q) = o;
    }
    __syncthreads();
}

__device__ __forceinline__ int t5_bucket_abs(int a) {
    if (a < 8) return a;
    if (a < 15) return 8; if (a < 27) return 9; if (a < 50) return 10; if (a < 91) return 11; if (a < 166) return 12; if (a < 305) return 13; if (a < 559) return 14; return 15;
}

__device__ __forceinline__ void convert_weights(const Args& A, LAS unsigned char* lds, int l, int first, int stride) {
    unsigned char* ws = A.ws;
    LAS float* scr = (LAS float*)lds;
    constexpr int I1 = 33 * 16, IP = 4 * 8, IO = 4 * 16, NIT = I1 + 2 * IP + IO;
    for (int it = first; it < NIT; it += stride) {
        int r = it;
        if (r < I1) { const int T = r / 16, kt = r % 16;
            const int kind = (T == 20 || T == 21) ? 1 : (T == 22 ? 2 : 0);
            transpose_item(scr, A.w_in + (size_t)l * 1024 * NIN, 1024, NIN, T * 256, kt * 64, (bf16*)(ws + WS_W1T) + (size_t)l * NIN * 1024, T * 256, kind); continue; }
        r -= I1;
        if (r < IP) { const int T = r / 8, kt = r % 8;
            transpose_item(scr, A.w_pa + (size_t)l * 512 * 1024, 512, 1024, T * 256, kt * 64, (bf16*)(ws + WS_WPAT) + (size_t)l * 1024 * 512, T * 256, 0); continue; }
        r -= IP;
        if (r < IP) { const int T = r / 8, kt = r % 8;
            transpose_item(scr, A.w_pb + (size_t)l * 512 * 1024, 512, 1024, T * 256, kt * 64, (bf16*)(ws + WS_WPBT) + (size_t)l * 1024 * 512, T * 256, 0); continue; }
        r -= IP;
        { const int T = r / 16, kt = r % 16;
            transpose_item(scr, A.w_o + (size_t)l * 1024 * 1024, 1024, 1024, T * 256, kt * 64, (bf16*)(ws + WS_WOT) + (size_t)l * 1024 * 1024, T * 256, 0); }
    }
}

__device__ __forceinline__ void p0_prologue(const Args& A, LAS unsigned char* lds) {
    const int tid = tid_fresh(), bx = blockIdx.x, G = gridDim.x;
    unsigned char* ws = A.ws;
    for (int it = bx; it < 96; it += G) {
        LAS float* sc = (LAS float*)lds;
        LAS float* red = sc + 4096;
        for (int e = tid; e < 4096; e += 512) { const float v = A.c[e]; sc[e] = v / (1.0f + __expf(-v)); }
        __syncthreads();
        const int l = it / 48, col = (it % 48) * 64 + (tid & 63), kc = tid >> 6;
        const float* w = A.w_ada + (size_t)l * 1024 * 3072 + col;
        float a0 = 0.f, a1 = 0.f, a2 = 0.f, a3 = 0.f;
#pragma unroll 8
        for (int k = kc * 128; k < kc * 128 + 128; ++k) { const float wv = w[(size_t)k * 3072]; a0 += sc[k] * wv; a1 += sc[1024 + k] * wv; a2 += sc[2048 + k] * wv; a3 += sc[3072 + k] * wv; }
        red[(kc * 4 + 0) * 64 + (tid & 63)] = a0; red[(kc * 4 + 1) * 64 + (tid & 63)] = a1; red[(kc * 4 + 2) * 64 + (tid & 63)] = a2; red[(kc * 4 + 3) * 64 + (tid & 63)] = a3;
        __syncthreads();
        if (tid < 256) { const int b = tid >> 6, cl = tid & 63; float s = 0.f;
#pragma unroll
            for (int q = 0; q < 8; ++q) s += red[(q * 4 + b) * 64 + cl];
            const int cc = (it % 48) * 64 + cl;
            ((float*)(ws + WS_MOD))[(l * 4 + b) * 3072 + cc] = s + A.b_ada[l * 3072 + cc]; }
        __syncthreads();
    }
    if (bx == G - 1) {
        float* rope = (float*)(ws + WS_ROPE);
        for (int e = tid; e < 128 * 16; e += 512) { const int pos = e >> 4, i = e & 15;
            const float inv = powf(10000.0f, -(float)(2 * i) / 32.0f); const float ang = (float)pos * inv;
            rope[2 * e] = cosf(ang); rope[2 * e + 1] = sinf(ang); }
        float* bias = (float*)(ws + WS_BIAS);
        for (int e = tid; e < 3 * 8 * 129; e += 512) { const int g = e / (8 * 129), r = e % (8 * 129), h = r / 129, idx = r % 129;
            const int rel = idx - 64, d = 1 << (2 * g), a = (rel < 0 ? -rel : rel) * d;
            const int bucket = (rel > 0 ? 16 : 0) + t5_bucket_abs(a);
            bias[(g * 8 + h) * 132 + idx] = A.rel[bucket * 24 + g * 8 + h] * LOG2E; }
    }
    convert_weights(A, lds, 0, (bx + 160) % G, G);
}

__device__ __forceinline__ void p_modulate(const Args& A) {
    const float* mod = (const float*)(A.ws + WS_MOD);
    bf16* U = (bf16*)(A.ws + WS_U);
    const size_t n8 = (size_t)MT * 1024 / 8;
    const int tidm = tid_fresh();
    for (size_t e = (size_t)blockIdx.x * 512 + tidm; e < n8; e += (size_t)gridDim.x * 512) {
        const int row = (int)(e >> 7), c8 = (int)(e & 127) * 8, b = row >> 13;
        const f32x4 x0 = *(const f32x4*)(A.x + (size_t)row * 1024 + c8), x1 = *(const f32x4*)(A.x + (size_t)row * 1024 + c8 + 4);
        const float* mb = mod + b * 3072 + c8;
        const f32x4 sh0 = *(const f32x4*)(mb), sh1 = *(const f32x4*)(mb + 4), sc0 = *(const f32x4*)(mb + 1024), sc1 = *(const f32x4*)(mb + 1028);
        const f32x4 u0 = x0 * (sc0 + 1.0f) + sh0, u1 = x1 * (sc1 + 1.0f) + sh1;
        u32x4 o; o.x = cvtpk(u0[0], u0[1]); o.y = cvtpk(u0[2], u0[3]); o.z = cvtpk(u1[0], u1[1]); o.w = cvtpk(u1[2], u1[3]);
        *(u32x4*)(U + (size_t)row * 1024 + c8) = o;
    }
}

__device__ __forceinline__ void p_layernorm(const Args& A, int l) {
    const int tidl = tid_fresh(); const int lane = tidl & 63, gw = blockIdx.x * 8 + (tidl >> 6), NGW = gridDim.x * 8;
    const float* lg = A.ln_g + l * 1024; const float* lb = A.ln_b + l * 1024;
    const float* mod = (const float*)(A.ws + WS_MOD) + (size_t)(l + 1) * 4 * 3072;
    bf16* U = (bf16*)(A.ws + WS_U);
    f32x4 gv[4], bv[4];
#pragma unroll
    for (int j = 0; j < 4; ++j) { gv[j] = *(const f32x4*)(lg + 4 * lane + 256 * j); bv[j] = *(const f32x4*)(lb + 4 * lane + 256 * j); }
    f32x4 vn[4];
#pragma unroll
    for (int j = 0; j < 4; ++j) vn[j] = *(const f32x4*)(A.out + (size_t)gw * 1024 + 4 * lane + 256 * j);
    for (int row = gw; row < MT; row += NGW) {
        float* xr = A.out + (size_t)row * 1024 + 4 * lane;
        f32x4 v[4]; float s = 0.f;
        const int rown = row + NGW < MT ? row + NGW : row;
#pragma unroll
        for (int j = 0; j < 4; ++j) { v[j] = vn[j]; s += (v[j][0] + v[j][1]) + (v[j][2] + v[j][3]); }
#pragma unroll
        for (int j = 0; j < 4; ++j) vn[j] = *(const f32x4*)(A.out + (size_t)rown * 1024 + 4 * lane + 256 * j);
        const float mean = wave_sum(s) * (1.0f / 1024.0f); float s2 = 0.f;
#pragma unroll
        for (int j = 0; j < 4; ++j) { v[j] = v[j] - mean; s2 += (v[j][0] * v[j][0] + v[j][1] * v[j][1]) + (v[j][2] * v[j][2] + v[j][3] * v[j][3]); }
        const float rstd = 1.0f / sqrtf(wave_sum(s2) * (1.0f / 1024.0f) + 1e-5f);
#pragma unroll
        for (int j = 0; j < 4; ++j) { v[j] = v[j] * rstd * gv[j] + bv[j]; *(f32x4*)(xr + 256 * j) = v[j]; }
        if (l + 1 < DEPTH) {
            const float* mb = mod + (row >> 13) * 3072 + 4 * lane;
#pragma unroll
            for (int j = 0; j < 4; ++j) { const f32x4 sh = *(const f32x4*)(mb + 256 * j), sc = *(const f32x4*)(mb + 1024 + 256 * j);
                const f32x4 u = v[j] * (sc + 1.0f) + sh;
                *(u64*)(U + (size_t)row * 1024 + 4 * lane + 256 * j) = (u64)cvtpk(u[0], u[1]) | ((u64)cvtpk(u[2], u[3]) << 32); }
        }
    }
}

constexpr int KST = 144, VST = 192;
typedef short v4i16_b __attribute__((ext_vector_type(4)));
__device__ __forceinline__ s16x4 lds_tr_b(const LAS unsigned char* p) { return __builtin_bit_cast(s16x4, __builtin_amdgcn_ds_read_tr16_b64_v4i16((LAS v4i16_b*)p)); }
constexpr int BUF_B = 64 * KST + 64 * VST;
__device__ __forceinline__ void attnB_unit(LAS unsigned char* lds, const Args& A, int unit, const float* kng, bool do_store = true) {
    const int tid = tid_fresh(), wave = tid >> 6, lane = tid & 63, ql = lane & 31, hh = lane >> 5;
    const int qblk = unit & 31, hq = (unit >> 5) & 7, b = unit >> 8, kvh = hq >> 2;
    const bf16* Qp = (const bf16*)(A.ws + WS_QB) + ((size_t)((b * 8 + hq) * 8192 + qblk * 256 + wave * 32 + ql) * 64);
    bf16x8 qf[4];
#pragma unroll
    for (int s = 0; s < 4; ++s) { const u32x4 qw = *(const u32x4*)(Qp + 16 * s + 8 * hh);
        u32x4 qs; qs.x = cvtpk(bflo(qw.x) * QK_C, bfhi(qw.x) * QK_C); qs.y = cvtpk(bflo(qw.y) * QK_C, bfhi(qw.y) * QK_C); qs.z = cvtpk(bflo(qw.z) * QK_C, bfhi(qw.z) * QK_C); qs.w = cvtpk(bflo(qw.w) * QK_C, bfhi(qw.w) * QK_C);
        qf[s] = __builtin_bit_cast(bf16x8, qs); }
    const int key = tid >> 3, ch = tid & 7;
    const bf16* Kg = (const bf16*)(A.ws + WS_KB) + ((size_t)((b * 2 + kvh) * 8192 + key) * 64 + ch * 8);
    const bf16* Vg = (const bf16*)(A.ws + WS_VB) + ((size_t)((b * 2 + kvh) * 8192 + key) * 64 + ch * 8);
    f32x16 o0, o1;
#pragma unroll
    for (int i = 0; i < 16; ++i) { o0[i] = 0.f; o1[i] = 0.f; }
    float m_used = -1e30f, l = 0.f; float lp[4] = {0.f, 0.f, 0.f, 0.f};
    u32x4 kreg = *(const u32x4*)Kg, vreg = *(const u32x4*)Vg;
    u32x4 kq1 = *(const u32x4*)(Kg + (size_t)64 * 64), vq1 = *(const u32x4*)(Vg + (size_t)64 * 64), kq0 = *(const u32x4*)(Kg + (size_t)2 * 64 * 64), vq0 = *(const u32x4*)(Vg + (size_t)2 * 64 * 64);
#define WRITE_TILE(bufp) do { LAS unsigned char* _k = (bufp); LAS unsigned char* _v = (bufp) + 64 * KST; \
        *(LAS u32x4*)(_k + key * KST + ch * 16) = kreg; \
        *(LAS u32x4*)(_v + key * VST + ch * 16) = vreg; } while (0)
#define QK_TILE(kbp, d0, d1) do { _Pragma("unroll") for (int s = 0; s < 4; ++s) { \
        const bf16x8 _k0 = *(const LAS bf16x8*)((kbp) + ql * KST + hh * 16 + 32 * s), _k1 = *(const LAS bf16x8*)((kbp) + (32 + ql) * KST + hh * 16 + 32 * s); \
        d0 = MFMA32(_k0, qf[s], d0); d1 = MFMA32(_k1, qf[s], d1); } } while (0)
    __syncthreads();
    WRITE_TILE(lds);
    kreg = kq1; vreg = vq1;
    WRITE_TILE(lds + BUF_B);
    __syncthreads();
    constexpr int NT = SEQ / 64;
    f32x16 c0, c1, d0, d1, o2;
#pragma unroll
    for (int i = 0; i < 16; ++i) { c0[i] = 0.f; c1[i] = 0.f; o2[i] = 0.f; }
    QK_TILE(lds, c0, c1);
    float mx = fmaxf(c0[0], c1[0]);
#pragma unroll
    for (int i = 1; i < 16; ++i) mx = fmaxf(mx, fmaxf(c0[i], c1[i]));
    mx = fmaxf(mx, __shfl_xor(mx, 32));
    float qn2 = 0.f;
#pragma unroll
    for (int s = 0; s < 4; ++s) { const u32x4 qw = __builtin_bit_cast(u32x4, qf[s]);
        qn2 += bflo(qw.x) * bflo(qw.x) + bfhi(qw.x) * bfhi(qw.x) + bflo(qw.y) * bflo(qw.y) + bfhi(qw.y) * bfhi(qw.y) + bflo(qw.z) * bflo(qw.z) + bfhi(qw.z) * bfhi(qw.z) + bflo(qw.w) * bflo(qw.w) + bfhi(qw.w) * bfhi(qw.w); }
    qn2 += __shfl_xor(qn2, 32);
    float gk = fabsf(kng[lane]);
#pragma unroll
    for (int o = 1; o < 64; o <<= 1) gk = fmaxf(gk, __shfl_xor(gk, o));
    const bool fast = __all(sqrtf(qn2) * 8.0f * gk * 1.05f <= 48.0f) != 0;
    if (fast) { m_used = 0.f; mx = 0.f; }
    else {
        m_used = mx;
#pragma unroll
        for (int i = 0; i < 16; ++i) { c0[i] -= m_used; c1[i] -= m_used; }
        mx = 0.f;
    }
    const short one_bits = ql == 0 ? (short)0x3F80 : (short)0;
    const bf16x8 ones = {one_bits, one_bits, one_bits, one_bits, one_bits, one_bits, one_bits, one_bits};
    int rb = 0;
#define SB() __builtin_amdgcn_sched_barrier(0)
#define PRI1() do {} while (0)
#define PRI0() do {} while (0)
#define VFRAG(ks, A0, A1) const LAS unsigned char* _vr##ks = vb + (16 * ks + 4 * hh + ((lane & 15) >> 2)) * VST + 32 * ((lane >> 4) & 1) + 8 * (lane & 3); \
        const bf16x8 A0 = __builtin_shufflevector(lds_tr_b(_vr##ks), lds_tr_b(_vr##ks + 8 * VST), 0, 1, 2, 3, 4, 5, 6, 7), A1 = __builtin_shufflevector(lds_tr_b(_vr##ks + 64), lds_tr_b(_vr##ks + 8 * VST + 64), 0, 1, 2, 3, 4, 5, 6, 7)
#define EXP4(C, i0) do { _Pragma("unroll") for (int i = (i0); i < (i0) + 4; ++i) C[i] = __builtin_amdgcn_exp2f(C[i]); } while (0)
#define E2(C, PW, k) do { C[2 * (k)] = __builtin_amdgcn_exp2f(C[2 * (k)]); C[2 * (k) + 1] = __builtin_amdgcn_exp2f(C[2 * (k) + 1]); PW[k] = cvtpk(C[2 * (k)], C[2 * (k) + 1]); lp[(k) & 3] += C[2 * (k)] + C[2 * (k) + 1]; } while (0)
#define PFRAG(PW, h) __builtin_bit_cast(bf16x8, (u32x4){PW[4 * (h)], PW[4 * (h) + 1], PW[4 * (h) + 2], PW[4 * (h) + 3]})
#define SUB4(N, i0) do { N[i0] -= m_used; N[(i0) + 1] -= m_used; N[(i0) + 2] -= m_used; N[(i0) + 3] -= m_used; } while (0)
#define SGB(mask, n) __builtin_amdgcn_sched_group_barrier(mask, n, 0)
#define AB_PIPE() do { SGB(0x020, 2); SGB(0x100, 8); SGB(0x400, 2); SGB(0x002, 1); \
        _Pragma("unroll") for (int _i = 0; _i < 8; ++_i) { SGB(0x008, 1); SGB(0x400, 2); SGB(0x002, 1); SGB(0x100, 1); } \
        _Pragma("unroll") for (int _i = 0; _i < 7; ++_i) { SGB(0x008, 1); SGB(0x400, 2); SGB(0x002, 1); } \
        _Pragma("unroll") for (int _i = 0; _i < 5; ++_i) { SGB(0x008, 1); SGB(0x002, 7); } } while (0)
#define AB_STEP(C0, C1, N0, N1, T, KL, VL, KW, VW, FAST) do { \
        if (!(FAST) && __any(mx > 8.0f)) {     \
            const float inc = fmaxf(mx, 0.f), alpha = __builtin_amdgcn_exp2f(-inc); m_used += inc; l *= alpha; lp[0] *= alpha; lp[1] *= alpha; lp[2] *= alpha; lp[3] *= alpha; \
            _Pragma("unroll") for (int i = 0; i < 16; ++i) { o0[i] *= alpha; o1[i] *= alpha; C0[i] -= inc; C1[i] -= inc; } } \
        const int rb1 = rb == 2 ? 0 : rb + 1, rb2 = rb1 == 2 ? 0 : rb1 + 1; \
        LAS unsigned char* kb1 = lds + rb1 * BUF_B; LAS unsigned char* vb = lds + rb * BUF_B + 64 * KST; \
        const int tn = (T) + 3 < NT ? (T) + 3 : NT - 1;     \
        KL = *(const u32x4*)(Kg + (size_t)tn * 64 * 64); VL = *(const u32x4*)(Vg + (size_t)tn * 64 * 64); \
        _Pragma("unroll") for (int i = 0; i < 16; ++i) { N0[i] = 0.f; N1[i] = 0.f; } \
        bf16x8 kf0[4], kf1[4]; \
        _Pragma("unroll") for (int s = 0; s < 4; ++s) { kf0[s] = *(const LAS bf16x8*)(kb1 + ql * KST + hh * 16 + 32 * s); kf1[s] = *(const LAS bf16x8*)(kb1 + (32 + ql) * KST + hh * 16 + 32 * s); } \
        unsigned pw0[8], pw1[8]; \
        E2(C0, pw0, 0); \
        N0 = MFMA32(kf0[0], qf[0], N0); E2(C0, pw0, 1); \
        N1 = MFMA32(kf1[0], qf[0], N1); E2(C0, pw0, 2); VFRAG(0, va0, vc0); \
        N0 = MFMA32(kf0[1], qf[1], N0); E2(C0, pw0, 3); \
        N1 = MFMA32(kf1[1], qf[1], N1); E2(C0, pw0, 4); VFRAG(1, va1, vc1); \
        N0 = MFMA32(kf0[2], qf[2], N0); E2(C0, pw0, 5); \
        N1 = MFMA32(kf1[2], qf[2], N1); E2(C0, pw0, 6); VFRAG(2, va2, vc2); \
        N0 = MFMA32(kf0[3], qf[3], N0); E2(C0, pw0, 7); \
        N1 = MFMA32(kf1[3], qf[3], N1); E2(C1, pw1, 0); VFRAG(3, va3, vc3); \
        const bf16x8 pf0 = PFRAG(pw0, 0), pf1 = PFRAG(pw0, 1); \
        o0 = MFMA32(va0, pf0, o0); E2(C1, pw1, 1); \
        o1 = MFMA32(vc0, pf0, o1); E2(C1, pw1, 2); \
        E2(C1, pw1, 3); \
        o0 = MFMA32(va1, pf1, o0); E2(C1, pw1, 4); \
        o1 = MFMA32(vc1, pf1, o1); E2(C1, pw1, 5); \
        E2(C1, pw1, 6); \
        const bf16x8 pf2 = PFRAG(pw1, 0); \
        o0 = MFMA32(va2, pf2, o0); E2(C1, pw1, 7); \
        const bf16x8 pf3 = PFRAG(pw1, 1); \
        o1 = MFMA32(vc2, pf2, o1); \
        o0 = MFMA32(va3, pf3, o0); \
        o1 = MFMA32(vc3, pf3, o1); \
        if (!(FAST)) { SUB4(N0, 0); SUB4(N0, 4); SUB4(N0, 8); SUB4(N0, 12); SUB4(N1, 0); SUB4(N1, 4); SUB4(N1, 8); SUB4(N1, 12); \
            float mxn = fmaxf(N0[0], N1[0]); \
            _Pragma("unroll") for (int i = 1; i < 16; ++i) mxn = fmaxf(mxn, fmaxf(N0[i], N1[i])); \
            mx = fmaxf(mxn, __shfl_xor(mxn, 32)); } \
        \
        kreg = KW; vreg = VW; WRITE_TILE(lds + rb2 * BUF_B); \
        asm volatile("s_waitcnt lgkmcnt(0)" ::: "memory"); __builtin_amdgcn_s_barrier(); asm volatile("" ::: "memory");     \
        rb = rb1; } while (0)
    if (fast) {
#pragma unroll 1
        for (int t = 0; t < NT; t += 2) { AB_STEP(c0, c1, d0, d1, t, kq1, vq1, kq0, vq0, true); AB_STEP(d0, d1, c0, c1, t + 1, kq0, vq0, kq1, vq1, true); }
    } else {
#pragma unroll 1
        for (int t = 0; t < NT; t += 2) { AB_STEP(c0, c1, d0, d1, t, kq1, vq1, kq0, vq0, false); AB_STEP(d0, d1, c0, c1, t + 1, kq0, vq0, kq1, vq1, false); }
    }
#undef AB_STEP
#undef AB_PIPE
#undef SGB
#undef SB
#undef PRI1
#undef PRI0
#undef E2
#undef PFRAG
#undef SUB4
#undef VFRAG
#undef EXP4
    l += (lp[0] + lp[1]) + (lp[2] + lp[3]);
    l += __shfl_xor(l, 32);
#undef WRITE_TILE
#undef QK_TILE
    const float inv = 1.0f / l;
    bf16* yrow = (bf16*)(A.ws + WS_SBZ) + ((size_t)(b * 8192 + qblk * 256 + wave * 32 + ql) * 512 + hq * 64 + 4 * hh);
    u32x2 zz[8];
#pragma unroll
    for (int g4 = 0; g4 < 4; ++g4) { zz[g4] = *(const u32x2*)(yrow + 8 * g4); zz[4 + g4] = *(const u32x2*)(yrow + 32 + 8 * g4); }
    if (do_store)
#pragma unroll
    for (int g4 = 0; g4 < 4; ++g4) {
        { bf16* p = yrow + 8 * g4; const u32x2 z = zz[g4];
          u32x2 w; w.x = cvtpk(o0[4 * g4] * inv * bflo(z.x), o0[4 * g4 + 1] * inv * bfhi(z.x)); w.y = cvtpk(o0[4 * g4 + 2] * inv * bflo(z.y), o0[4 * g4 + 3] * inv * bfhi(z.y)); *(u32x2*)p = w; }
        { bf16* p = yrow + 32 + 8 * g4; const u32x2 z = zz[4 + g4];
          u32x2 w; w.x = cvtpk(o1[4 * g4] * inv * bflo(z.x), o1[4 * g4 + 1] * inv * bfhi(z.x)); w.y = cvtpk(o1[4 * g4 + 2] * inv * bflo(z.y), o1[4 * g4 + 3] * inv * bfhi(z.y)); *(u32x2*)p = w; }
    }
}

constexpr int AST = 144;
constexpr int A_BIAS_OFF = 0, A_K_OFF = 4096, A_V_OFF = A_K_OFF + 384 * AST;
static_assert(A_V_OFF + 384 * AST <= LDS_BYTES, "mixer A LDS map");
typedef short v4i16_t __attribute__((ext_vector_type(4)));
__device__ __forceinline__ s16x4 lds_tr(const LAS unsigned char* p) { return __builtin_bit_cast(s16x4, __builtin_amdgcn_ds_read_tr16_b64_v4i16((LAS v4i16_t*)p)); }
__device__ __forceinline__ void attnA_unit(LAS unsigned char* lds, const Args& A, int unit) {
    const int tid = tid_fresh(), wave = tid >> 6, lane = tid & 63, ql = lane & 31, hh = lane >> 5;
    const int c = unit & 7, h = (unit >> 3) & 7, b = unit >> 6;
    LAS float* biasl = (LAS float*)(lds + A_BIAS_OFF);
    LAS unsigned char* kt_l = lds + A_K_OFF; LAS unsigned char* vt_l = lds + A_V_OFF;
    __syncthreads();
    for (int e = tid; e < 3 * 192; e += 512) { const int g = e / 192, idx = e % 192 - 32;
        biasl[e] = (idx >= 0 && idx <= 128) ? ((const float*)(A.ws + WS_BIAS))[(g * 8 + h) * 132 + idx] : -1e30f; }
    float* LSE = (float*)(A.ws + WS_LSE);
    const int srow = tid >> 3, sch = tid & 7;
#pragma unroll 1
    for (int g = 0; g < 3; ++g) {
        const int lg = 2 * g, L = 8192 >> lg, nsb = g == 2 ? 8 : 4;
        const size_t bgh = (size_t)((b * 3 + g) * 8 + h) * 8192;
        bf16* Qg = (bf16*)(A.ws + WS_QA) + bgh * 64; const bf16* Kg = (const bf16*)(A.ws + WS_KA) + bgh * 64; const bf16* Vg = (const bf16*)(A.ws + WS_VA) + bgh * 64;
        const LAS float* bl = biasl + g * 192;
        const bool active = g < 2 || wave < 4;
#define A_GEOM(SB, ROW, PB, KI) do { if (g == 2) { const int _p = (ROW) >= 192 ? 1 : 0; PB = (2 * (SB) + _p) * L; KI = c * 64 - 64 + (ROW) - 192 * _p; } \
            else { PB = (g == 0 ? 0 : (SB)) * L; KI = (g == 0 ? c * 1024 + (SB) * 256 : c * 256) - 64 + (ROW); } } while (0)
#define A_QPOS(SB, PB, I0, RB) do { if (g == 2) { const int _p = wave >> 1; PB = (2 * (SB) + _p) * L; I0 = c * 64 + 32 * (wave & 1); RB = 192 * _p + 32 * (wave & 1); } \
            else { PB = (g == 0 ? 0 : (SB)) * L; I0 = (g == 0 ? c * 1024 + (SB) * 256 : c * 256) + 32 * wave; RB = 32 * wave; } } while (0)
#define A_LOAD(SB) do { _Pragma("unroll") for (int it = 0; it < 6; ++it) { int pb, ki; A_GEOM(SB, it * 64 + srow, pb, ki); ki = ki < 0 ? 0 : (ki > L - 1 ? L - 1 : ki); \
                const size_t off = (size_t)(pb + ki) * 64 + sch * 8; kst[it] = *(const u32x4*)(Kg + off); vst[it] = *(const u32x4*)(Vg + off); } \
            } while (0)
#define A_LOADQ(SB) do { if (active) { int pb, i0, rbq; A_QPOS(SB, pb, i0, rbq); const bf16* qr = Qg + (size_t)(pb + i0 + ql) * 64 + 8 * hh; \
                _Pragma("unroll") for (int s = 0; s < 4; ++s) qf[s] = *(const bf16x8*)(qr + 16 * s); } } while (0)
#define A_STORE() do { _Pragma("unroll") for (int it = 0; it < 6; ++it) { *(LAS u32x4*)(kt_l + (it * 64 + srow) * AST + sch * 16) = kst[it]; *(LAS u32x4*)(vt_l + (it * 64 + srow) * AST + sch * 16) = vst[it]; } } while (0)
        u32x4 kst[6], vst[6]; bf16x8 qf[4];
        A_LOAD(0); A_LOADQ(0);
        __syncthreads();
        A_STORE();
        __syncthreads();
#pragma unroll 1
        for (int sb = 0; sb < nsb; ++sb) {
            if (sb + 1 < nsb) A_LOAD(sb + 1);
            if (active) {
                int pbase, i0, rb; A_QPOS(sb, pbase, i0, rb);
                bf16* Qrow = Qg + (size_t)(pbase + i0 + ql) * 64;
                f32x16 S[5];
#pragma unroll
                for (int kt = 0; kt < 5; ++kt)
#pragma unroll
                    for (int i = 0; i < 16; ++i) S[kt][i] = 0.f;
#pragma unroll
                for (int s = 0; s < 4; ++s)
#pragma unroll
                    for (int kt = 0; kt < 5; ++kt) S[kt] = MFMA32(*(const LAS bf16x8*)(kt_l + (rb + 32 * kt + ql) * AST + hh * 16 + 32 * s), qf[s], S[kt]);
                asm volatile("" : "+v"(S[4][15]));
                if (sb + 1 < nsb) { A_LOADQ(sb + 1); }
                const bool edge = (i0 < 64) || (i0 + 96 > L);
                float mxp[2] = {-1e30f, -1e30f};
#pragma unroll
                for (int kt = 0; kt < 5; ++kt)
#pragma unroll
                    for (int i = 0; i < 16; ++i) {
                        const int cr = crow(i, 0);
                        float v = S[kt][i] * QK_C + bl[32 * kt + cr + 4 * hh - ql + 32];
                        if (edge) { const int kidx = i0 - 64 + 32 * kt + cr + 4 * hh; if (kidx < 0 || kidx >= L) v = -1e30f; }
                        S[kt][i] = v; mxp[i & 1] = fmaxf(mxp[i & 1], v);
                    }
                float mx = fmaxf(mxp[0], mxp[1]);
                mx = fmaxf(mx, __shfl_xor(mx, 32));
                float lsp[2] = {0.f, 0.f};
#pragma unroll
                for (int kt = 0; kt < 5; ++kt)
#pragma unroll
                    for (int i = 0; i < 16; ++i) { const float p = __builtin_amdgcn_exp2f(S[kt][i] - mx); S[kt][i] = p; lsp[i & 1] += p; }
                float ls = lsp[0] + lsp[1];
                ls += __shfl_xor(ls, 32);
                f32x16 o0, o1;
#pragma unroll
                for (int i = 0; i < 16; ++i) { o0[i] = 0.f; o1[i] = 0.f; }
                const LAS unsigned char* vr0 = vt_l + (rb + 4 * hh + ((lane & 15) >> 2)) * AST + 32 * ((lane >> 4) & 1) + 8 * (lane & 3);
#pragma unroll
                for (int kt = 0; kt < 5; ++kt)
#pragma unroll
                    for (int ks = 0; ks < 2; ++ks) {
                        const bf16x8 pf = pack_frag(S[kt], ks);
                        const LAS unsigned char* vr = vr0 + (32 * kt + 16 * ks) * AST;
                        const s16x4 a0 = lds_tr(vr), a1 = lds_tr(vr + 8 * AST), c0 = lds_tr(vr + 64), c1 = lds_tr(vr + 8 * AST + 64);
                        o0 = MFMA32(__builtin_shufflevector(a0, a1, 0, 1, 2, 3, 4, 5, 6, 7), pf, o0);
                        o1 = MFMA32(__builtin_shufflevector(c0, c1, 0, 1, 2, 3, 4, 5, 6, 7), pf, o1);
                    }
                const float inv = 1.0f / ls;
                bf16* orow = Qrow + 4 * hh;
#pragma unroll
                for (int g4 = 0; g4 < 4; ++g4) {
                    u32x2 w; w.x = cvtpk(o0[4 * g4] * inv, o0[4 * g4 + 1] * inv); w.y = cvtpk(o0[4 * g4 + 2] * inv, o0[4 * g4 + 3] * inv); *(u32x2*)(orow + 8 * g4) = w;
                    u32x2 z; z.x = cvtpk(o1[4 * g4] * inv, o1[4 * g4 + 1] * inv); z.y = cvtpk(o1[4 * g4 + 2] * inv, o1[4 * g4 + 3] * inv); *(u32x2*)(orow + 32 + 8 * g4) = z;
                }
                if (hh == 0) LSE[(size_t)((g * 4 + b) * 8 + h) * 8192 + pbase + i0 + ql] = mx + __builtin_amdgcn_logf(ls);
            }
            __syncthreads();
            if (sb + 1 < nsb) { A_STORE(); __syncthreads(); }
        }
#undef A_GEOM
#undef A_QPOS
#undef A_LOAD
#undef A_LOADQ
#undef A_STORE
    }
    __syncthreads();
    bf16* SAZ = (bf16*)(A.ws + WS_SAZ);
#pragma unroll 1
    for (int it0 = 0; it0 < 16; it0 += 4) {
        float ls2[4][3]; u32x4 og[4][3], zv[4];
#pragma unroll
        for (int q = 0; q < 4; ++q) {
            const int e = (it0 + q) * 512 + tid, tl = e >> 3, ch = e & 7, s = c * 1024 + tl;
#pragma unroll
            for (int g = 0; g < 3; ++g) { const int lg = 2 * g, p = ((s & ((1 << lg) - 1)) << (13 - lg)) | (s >> lg);
                ls2[q][g] = LSE[(size_t)((g * 4 + b) * 8 + h) * 8192 + p];
                og[q][g] = *(const u32x4*)((const bf16*)(A.ws + WS_QA) + ((size_t)((b * 3 + g) * 8 + h) * 8192 + p) * 64 + ch * 8); }
            zv[q] = *(const u32x4*)(SAZ + (size_t)(b * 8192 + s) * 512 + h * 64 + ch * 8);
        }
#pragma unroll
        for (int q = 0; q < 4; ++q) {
            const int e = (it0 + q) * 512 + tid, tl = e >> 3, ch = e & 7, s = c * 1024 + tl;
            const float M = fmaxf(ls2[q][0], fmaxf(ls2[q][1], ls2[q][2]));
            float w0 = __builtin_amdgcn_exp2f(ls2[q][0] - M), w1 = __builtin_amdgcn_exp2f(ls2[q][1] - M), w2 = __builtin_amdgcn_exp2f(ls2[q][2] - M);
            const float wi = 1.0f / (w0 + w1 + w2); w0 *= wi; w1 *= wi; w2 *= wi;
            const u32x4 z = zv[q]; u32x4 o;
#define CMB(f) { const float lo = (w0 * bflo(og[q][0].f) + w1 * bflo(og[q][1].f) + w2 * bflo(og[q][2].f)) * bflo(z.f); const float hi = (w0 * bfhi(og[q][0].f) + w1 * bfhi(og[q][1].f) + w2 * bfhi(og[q][2].f)) * bfhi(z.f); o.f = cvtpk(lo, hi); }
            CMB(x) CMB(y) CMB(z) CMB(w)
#undef CMB
            *(u32x4*)(SAZ + (size_t)(b * 8192 + s) * 512 + h * 64 + ch * 8) = o;
        }
    }
}


constexpr size_t WS_BAR = 240 * 1024;
__device__ __forceinline__ void grid_barrier(unsigned* bar, unsigned& target) {
    asm volatile("s_waitcnt vmcnt(0) lgkmcnt(0)" ::: "memory");
    __syncthreads();
    if (threadIdx.x == 0) {
        target += gridDim.x;
        unsigned* genw = bar + 64;
        __builtin_amdgcn_fence(__ATOMIC_RELEASE, "agent");
        asm volatile("s_waitcnt vmcnt(0)" ::: "memory");
        const unsigned old = __hip_atomic_fetch_add(bar, 1u, __ATOMIC_RELAXED, __HIP_MEMORY_SCOPE_AGENT);
        if (old + 1u == target) {
            __builtin_amdgcn_fence(__ATOMIC_ACQUIRE, "agent"); __builtin_amdgcn_fence(__ATOMIC_RELEASE, "agent");
            __hip_atomic_store(genw, target, __ATOMIC_RELAXED, __HIP_MEMORY_SCOPE_AGENT);
        } else {
            unsigned spins = 0;
            while (__hip_atomic_load(genw, __ATOMIC_RELAXED, __HIP_MEMORY_SCOPE_AGENT) < target) { __builtin_amdgcn_s_sleep(8); if (++spins > (1u << 22)) break; }
        }
        __builtin_amdgcn_fence(__ATOMIC_ACQUIRE, "agent");
        asm volatile("s_waitcnt vmcnt(0)" ::: "memory");
    }
    __syncthreads();
}

__global__ void __launch_bounds__(512, 2) fwd_kernel(Args A) {
    extern __shared__ __attribute__((aligned(16))) unsigned char lds_raw[];
    LAS unsigned char* lds = (LAS unsigned char*)lds_raw;
    PG8_LAS unsigned char* glds = (PG8_LAS unsigned char*)lds_raw;
    const int lo = A.ph_lo, hi = A.ph_hi, G = gridDim.x, bx = blockIdx.x;
    unsigned char* ws = A.ws;
#define IN(k) (lo <= (k) && (k) < hi)
    unsigned bar_target = 0u; unsigned* bar_word = (unsigned*)(ws + WS_BAR);
#define SEAM(k) do { if (IN(k) && IN((k) + 1)) { grid_barrier(bar_word, bar_target); } } while (0)
    if (A.coop == 12345) cg::this_grid().sync();
    int ph = 0;

    if (IN(ph)) p0_prologue(A, lds);

    SEAM(ph); ++ph;
    if (IN(ph)) p_modulate(A);
    SEAM(ph); ++ph;
#pragma unroll 1
    for (int l = 0; l < DEPTH; ++l) {
        const pg8::bf16_t* W1T = (const pg8::bf16_t*)(ws + WS_W1T) + (size_t)l * NIN * 1024;
        const bool gates_in_p1 = (l == 0);
        const pg8::bf16_t* Gbuf = gates_in_p1 ? (const pg8::bf16_t*)A.out : (const pg8::bf16_t*)(ws + WS_G);
        if (IN(ph)) {
            const int n1 = gates_in_p1 ? NIN : N1;
            pg8::Gemm g{(const pg8::bf16_t*)(ws + WS_U), W1T, MT, n1, 1024}; pg8::StaticOrder S; S.init(MT, n1, G, bx);
            pg8::Epi1 E{ws, A.qng + l * 64, A.kng + l * 64, (const float*)(ws + WS_ROPE), (pg8::bf16_t*)A.out, A.b_gate + l * 2048};

            pg8::gemm_phase<pg8::Epi1, pg8::StaticOrder, true, true>(glds, g, S, E);
            if (l + 1 < DEPTH) {
                const int nwg = (MT / 256) * (n1 / 256), rem = nwg % G;
                if (rem == 0) convert_weights(A, lds, l + 1, bx, G); else if (bx >= rem) convert_weights(A, lds, l + 1, bx - rem, G - rem);
            }

        }
        SEAM(ph); ++ph;
        if (IN(ph)) {
            for (int u = bx; u < 256 + 1024; u += G) {
                if (u < 256) attnA_unit(lds, A, u);
                if (u >= 256) {
                    int ub = u - 256;
                    if (G == 256) {
                        const int k = ub >> 8, xcd = bx & 7, j = (bx >> 3) * 4 + k;
                        ub = (xcd >> 1) * 256 + ((xcd & 1) * 4 + (j >> 5)) * 32 + (j & 31); }
                    attnB_unit(lds, A, ub, A.kng + l * 64);
                }
 }
            __syncthreads();
        }
        SEAM(ph); ++ph;
        if (IN(ph) && !gates_in_p1) {
            pg8::Gemm g{(const pg8::bf16_t*)(ws + WS_U), W1T + (size_t)N1 * 1024, MT, 2048, 1024}; pg8::GateOrder S; S.init(MT, G, bx);
            pg8::EpiGate E{(pg8::bf16_t*)(ws + WS_G), A.b_gate + l * 2048};

            pg8::gemm_phase<pg8::EpiGate, pg8::GateOrder, true, true>(glds, g, S, E);

        }
        if (IN(ph)) {
            { constexpr int DPM = (int)((WS_SBZ - WS_SAZ) / (256 * 512 * 2)), DPN = (int)((WS_WPBT - WS_WPAT) / (256 * 512 * 2));
              static_assert((size_t)DPM * 256 * 512 * 2 == WS_SBZ - WS_SAZ && (size_t)DPN * 256 * 512 * 2 == WS_WPBT - WS_WPAT && DPM >= MT / 256, "pass b of the merge is reached by whole-tile offsets");
              pg8::Gemm g{(const pg8::bf16_t*)(ws + WS_SAZ), (const pg8::bf16_t*)(ws + WS_WPAT) + (size_t)l * 1024 * 512, MT, 1024, 512}; pg8::MergeOrder S; S.init(MT, G, bx, DPM, DPN);
              pg8::EpiMerge2 E{(pg8::bf16_t*)(ws + WS_MG), Gbuf, DPM, DPN};
              pg8::gemm_phase<pg8::EpiMerge2, pg8::MergeOrder, true, true>(glds, g, S, E); }
        }
        SEAM(ph); ++ph;
        if (IN(ph)) {
            pg8::Gemm g{(const pg8::bf16_t*)(ws + WS_MG), (const pg8::bf16_t*)(ws + WS_WOT) + (size_t)l * 1024 * 1024, MT, 1024, 1024}; pg8::StaticOrder S; S.init(MT, 1024, G, bx);
            pg8::EpiOut E{l == 0 ? A.x : A.out, A.out, (const float*)(ws + WS_MOD) + (size_t)l * 4 * 3072 + 2048, ALPHA};

            pg8::gemm_phase<pg8::EpiOut, pg8::StaticOrder, true, true>(glds, g, S, E);

        }
        SEAM(ph); ++ph;

        if (IN(ph)) p_layernorm(A, l);

        SEAM(ph); ++ph;
    }
#undef IN
#undef SEAM
}
constexpr int N_PHASES = 2 + 5 * DEPTH;

#ifndef MK_SPLIT
#define MK_SPLIT 0
#endif
extern "C" void kernel_launch(void* const* d_in, const int* in_sizes, int n_in, void* d_out, int out_size, void* d_ws, size_t ws_size, hipStream_t stream) {
    static int grid = 0;
    if (grid == 0) {
        if (n_in != 14 || in_sizes[0] != MT * DM || out_size != MT * DM || ws_size < WS_END) { fprintf(stderr, "kernel_launch: unexpected shapes (n_in %d, ws %zu < %zu)\n", n_in, ws_size, (size_t)WS_END); grid = -1; return; }
        int dev = 0, cus = 0, per_cu = 0;
        hipGetDevice(&dev); hipDeviceGetAttribute(&cus, hipDeviceAttributeMultiprocessorCount, dev);
        if (hipFuncSetAttribute((const void*)fwd_kernel, hipFuncAttributeMaxDynamicSharedMemorySize, LDS_BYTES) != hipSuccess) { fprintf(stderr, "kernel_launch: hipFuncSetAttribute failed\n"); grid = -1; return; }
        if (hipOccupancyMaxActiveBlocksPerMultiprocessor(&per_cu, (const void*)fwd_kernel, 512, LDS_BYTES) != hipSuccess || per_cu < 1) { fprintf(stderr, "kernel_launch: occupancy query says %d\n", per_cu); per_cu = 1; }
        (void)hipGetLastError();
        grid = cus * 1;
    }
    if (grid < 0) return;
    Args a{};
    a.x = (const float*)d_in[0]; a.c = (const float*)d_in[1]; a.rel = (const float*)d_in[2]; a.ln_g = (const float*)d_in[3]; a.ln_b = (const float*)d_in[4];
    a.w_ada = (const float*)d_in[5]; a.b_ada = (const float*)d_in[6]; a.w_in = (const float*)d_in[7]; a.b_gate = (const float*)d_in[8];
    a.qng = (const float*)d_in[9]; a.kng = (const float*)d_in[10]; a.w_pa = (const float*)d_in[11]; a.w_pb = (const float*)d_in[12]; a.w_o = (const float*)d_in[13];
    a.out = (float*)d_out; a.ws = (unsigned char*)d_ws; a.pad = 0;
#if MK_SPLIT
    for (int p = 0; p < N_PHASES; ++p) { a.ph_lo = p; a.ph_hi = p + 1; a.coop = 0;
        hipLaunchKernelGGL(fwd_kernel, dim3(grid), dim3(512), LDS_BYTES, stream, a); }
#else
    if (hipMemsetAsync((char*)d_ws + WS_BAR, 0, 512, stream) != hipSuccess) { fprintf(stderr, "kernel_launch: memset failed\n"); return; }
    a.ph_lo = 0; a.ph_hi = N_PHASES; a.coop = 1;
    void* kargs[] = {&a};
    hipError_t e = hipLaunchCooperativeKernel((const void*)fwd_kernel, dim3(grid), dim3(512), kargs, LDS_BYTES, stream);
    if (e != hipSuccess) fprintf(stderr, "kernel_launch: cooperative launch failed: %s (grid %d)\n", hipGetErrorString(e), grid);
#endif
}
```
